# Optimizing an MI355X kernel written in HIP

```python
import jax, jax.numpy as jnp
from jax import lax
import numpy as np

D_MODEL = 1024
BATCH = 4
SEQ = 4096
DEPTH = 4

EPS = 1e-6
N_BRANCH = 4
BRANCH_WIDTH = D_MODEL // 2
GM_HEADS = 4
GM_CHUNK = 128
POOL_WINDOWS = (2, 4, 8, 16)
POOL_GROUP = BRANCH_WIDTH // len(POOL_WINDOWS)
ATT_HEADS = 4
ATT_HEAD_DIM = BRANCH_WIDTH // ATT_HEADS
DIL_PATTERNS = ((128, 1), (512, 4), (2048, 16))
N_DIL = len(DIL_PATTERNS)
ATT_BLOCK = 128
MEM_LEN = 256
MEM_HEADS = 4
MEM_HEAD_DIM = BRANCH_WIDTH // MEM_HEADS
NEG = -1e30

IN_SIZES = (2 * BRANCH_WIDTH, BRANCH_WIDTH,
            BRANCH_WIDTH, BRANCH_WIDTH,
            N_DIL * BRANCH_WIDTH, BRANCH_WIDTH, BRANCH_WIDTH, BRANCH_WIDTH,
            BRANCH_WIDTH, BRANCH_WIDTH,
            N_BRANCH * D_MODEL)
D_IN = sum(IN_SIZES)

kernel_name = "hybrid_gmlp_pool_dilated_attn_mem"


def rms_norm(x, g):
    xf = x.astype(jnp.float32)
    y = xf * lax.rsqrt(jnp.mean(xf * xf, axis=-1, keepdims=True) + EPS)
    return (y * g.astype(jnp.float32)).astype(x.dtype)


def layer_norm(x, g, b):
    xf = x.astype(jnp.float32)
    mu = jnp.mean(xf, axis=-1, keepdims=True)
    var = jnp.mean(jnp.square(xf - mu), axis=-1, keepdims=True)
    y = (xf - mu) * lax.rsqrt(var + EPS)
    return (y * g.astype(jnp.float32) + b.astype(jnp.float32)).astype(x.dtype)


def split_cols(h):
    idx = np.cumsum(np.array(IN_SIZES))[:-1].tolist()
    return jnp.split(h, idx, axis=-1)


def gmlp_spatial_gating(uv, ln_g, ln_b, w_s, b_s):
    u, v = jnp.split(jax.nn.gelu(uv, approximate=False), 2, axis=-1)
    v = layer_norm(v, ln_g, ln_b)
    B_, S_, W = v.shape
    nc = S_ // GM_CHUNK
    vh = v.reshape(B_, nc, GM_CHUNK, GM_HEADS, W // GM_HEADS)
    causal = jnp.tril(jnp.ones((GM_CHUNK, GM_CHUNK), dtype=bool))
    w = jnp.where(causal[None], w_s, jnp.zeros_like(w_s)).astype(v.dtype)
    mixed = jnp.einsum('hts,bcshe->bcthe', w, vh) + b_s.T.astype(v.dtype)[None, None, :, :, None]
    return u * mixed.reshape(B_, S_, W)


def multiscale_pool(p, pool_w, pool_scale):
    B_, S_, W = p.shape
    pf = p.astype(jnp.float32)
    cs = jnp.cumsum(pf, axis=1)
    count = jnp.arange(1, S_ + 1, dtype=jnp.float32)
    outs = []
    for g, win in enumerate(POOL_WINDOWS):
        c = cs[..., g * POOL_GROUP:(g + 1) * POOL_GROUP]
        prev = jnp.pad(c, ((0, 0), (win, 0), (0, 0)))[:, :S_]
        mean = (c - prev) / jnp.minimum(count, float(win))[None, :, None]
        outs.append(mean - pf[..., g * POOL_GROUP:(g + 1) * POOL_GROUP])
    d = jnp.stack(outs, axis=2)
    y = jnp.einsum('bsgi,gio->bsgo', d, pool_w.astype(jnp.float32)).reshape(B_, S_, W)
    return (y * pool_scale.astype(jnp.float32)).astype(p.dtype)


def dilated_window_attention(q, k, v, window, dilation):
    B_, S_, H, E = q.shape
    n_back = window // dilation
    L = S_ // dilation
    nb = -(-L // ATT_BLOCK)
    Lp = nb * ATT_BLOCK

    def to_blocks(t):
        t = t.reshape(B_, L, dilation, H, E).transpose(0, 2, 1, 3, 4)
        t = jnp.pad(t, ((0, 0), (0, 0), (0, Lp - L), (0, 0), (0, 0)))
        return t.reshape(B_, dilation, nb, ATT_BLOCK, H, E)

    def with_prev(t):
        prev = jnp.pad(t, ((0, 0), (0, 0), (1, 0), (0, 0), (0, 0), (0, 0)))[:, :, :nb]
        return jnp.concatenate([prev, t], axis=3)

    qb = to_blocks(q).astype(jnp.float32)
    kk = with_prev(to_blocks(k)).astype(jnp.float32)
    vv = with_prev(to_blocks(v)).astype(jnp.float32)
    s = jnp.einsum('brnqhe,brnkhe->brnhqk', qb, kk) * (E ** -0.5)
    i = jnp.arange(ATT_BLOCK)[:, None]
    j = jnp.arange(2 * ATT_BLOCK)[None, :]
    dist = ATT_BLOCK + i - j
    band = (dist >= 0) & (dist <= n_back)
    key_exists = (jnp.arange(nb)[:, None] > 0) | (jnp.arange(2 * ATT_BLOCK)[None, :] >= ATT_BLOCK)
    valid = band[None] & key_exists[:, None, :]
    s = jnp.where(valid[None, None, :, None], s, NEG)
    m = jnp.max(s, axis=-1, keepdims=True)
    e = jnp.exp(s - m)
    den = jnp.sum(e, axis=-1, keepdims=True)
    o = jnp.einsum('brnhqk,brnkhe->brnqhe', e / den, vv)
    lse = (m + jnp.log(den))[..., 0]
    o = o.reshape(B_, dilation, Lp, H, E)[:, :, :L].transpose(0, 2, 1, 3, 4).reshape(B_, S_, H, E)
    lse = lse.transpose(0, 1, 2, 4, 3).reshape(B_, dilation, Lp, H)[:, :, :L]
    lse = lse.transpose(0, 2, 1, 3).reshape(B_, S_, H)
    return o, lse


def dilated_mixture(c_q, c_k, c_v):
    B_, S_, _ = c_q.shape
    qg = c_q.reshape(B_, S_, N_DIL, ATT_HEADS, ATT_HEAD_DIM)
    k = c_k.reshape(B_, S_, ATT_HEADS, ATT_HEAD_DIM)
    v = c_v.reshape(B_, S_, ATT_HEADS, ATT_HEAD_DIM)
    outs, lses = [], []
    for g, (win, dil) in enumerate(DIL_PATTERNS):
        o, l = dilated_window_attention(qg[:, :, g], k, v, win, dil)
        outs.append(o)
        lses.append(l)
    alpha = jax.nn.softmax(jnp.stack(lses, axis=0), axis=0)
    o = jnp.sum(alpha[..., None] * jnp.stack(outs, axis=0), axis=0)
    return o.reshape(B_, S_, BRANCH_WIDTH).astype(c_q.dtype)


def memory_attention(m_q, mem_n, w_kv):
    B_, S_, _ = m_q.shape
    q = m_q.reshape(B_, S_, MEM_HEADS, MEM_HEAD_DIM).astype(jnp.float32)
    k, v = jnp.split(mem_n @ w_kv, 2, axis=-1)
    k = k.reshape(B_, -1, MEM_HEADS, MEM_HEAD_DIM).astype(jnp.float32)
    v = v.reshape(B_, -1, MEM_HEADS, MEM_HEAD_DIM).astype(jnp.float32)
    s = jnp.einsum('bshe,bmhe->bhsm', q, k) * (MEM_HEAD_DIM ** -0.5)
    p = jax.nn.softmax(s, axis=-1)
    o = jnp.einsum('bhsm,bmhe->bshe', p, v)
    return o.reshape(B_, S_, BRANCH_WIDTH).astype(m_q.dtype)


def setup_inputs(seed: int = 0) -> dict:
    key = jax.random.key(seed)
    ks = jax.random.split(key, 20)
    f32 = jnp.float32
    nrm = lambda k, shape, s: jax.random.normal(k, shape, f32) * s
    return {
        "x": nrm(ks[0], (BATCH, SEQ, D_MODEL), 1.0),
        "mem": nrm(ks[1], (BATCH, MEM_LEN, D_MODEL), 1.0),
        "norm_g": 1.0 + nrm(ks[2], (DEPTH, D_MODEL), 0.02),
        "w_in": nrm(ks[3], (DEPTH, D_MODEL, D_IN), D_MODEL ** -0.5),
        "gm_ln_g": 1.0 + nrm(ks[4], (DEPTH, BRANCH_WIDTH), 0.02),
        "gm_ln_b": nrm(ks[5], (DEPTH, BRANCH_WIDTH), 0.02),
        "gm_ws": nrm(ks[6], (DEPTH, GM_HEADS, GM_CHUNK, GM_CHUNK), GM_CHUNK ** -0.5),
        "gm_bs": 1.0 + nrm(ks[7], (DEPTH, GM_HEADS, GM_CHUNK), 0.1),
        "pool_w": nrm(ks[8], (DEPTH, len(POOL_WINDOWS), POOL_GROUP, POOL_GROUP), POOL_GROUP ** -0.5),
        "pool_scale": 1.0 + nrm(ks[9], (DEPTH, BRANCH_WIDTH), 0.1),
        "mem_norm_g": 1.0 + nrm(ks[10], (DEPTH, D_MODEL), 0.02),
        "w_mem_kv": nrm(ks[11], (DEPTH, D_MODEL, 2 * BRANCH_WIDTH), D_MODEL ** -0.5),
        "w_branch": nrm(ks[12], (DEPTH, N_BRANCH, BRANCH_WIDTH, D_MODEL), BRANCH_WIDTH ** -0.5),
        "w_out": nrm(ks[13], (DEPTH, D_MODEL, D_MODEL), 0.5 * D_MODEL ** -0.5),
        "final_norm_g": 1.0 + nrm(ks[14], (D_MODEL,), 0.02),
    }


def reference(x, mem, norm_g, w_in, gm_ln_g, gm_ln_b, gm_ws, gm_bs, pool_w, pool_scale,
              mem_norm_g, w_mem_kv, w_branch, w_out, final_norm_g):
    B_, S_, D = x.shape
    for l in range(DEPTH):
        h = rms_norm(x, norm_g[l])
        proj = h @ w_in[l]
        (a_uv, a_gate, p_in, p_gate, c_q, c_k, c_v, c_gate,
         m_q, m_gate, g_merge) = split_cols(proj)
        y_a = gmlp_spatial_gating(a_uv, gm_ln_g[l], gm_ln_b[l], gm_ws[l], gm_bs[l]) * jax.nn.silu(a_gate)
        y_p = multiscale_pool(p_in, pool_w[l], pool_scale[l]) * jax.nn.silu(p_gate)
        y_c = dilated_mixture(c_q, c_k, c_v) * jax.nn.silu(c_gate)
        mem_n = rms_norm(mem, mem_norm_g[l])
        y_m = memory_attention(m_q, mem_n, w_mem_kv[l]) * jax.nn.silu(m_gate)
        gates = jax.nn.sigmoid(g_merge.reshape(B_, S_, N_BRANCH, D))
        z = (gates[:, :, 0] * (y_a @ w_branch[l, 0])
             + gates[:, :, 1] * (y_p @ w_branch[l, 1])
             + gates[:, :, 2] * (y_c @ w_branch[l, 2])
             + gates[:, :, 3] * (y_m @ w_branch[l, 3]))
        x = x + z @ w_out[l]
    return rms_norm(x, final_norm_g)
```

```cpp
#include <hip/hip_runtime.h>
#include <hip/hip_cooperative_groups.h>
#include <cstdio>
#include <cstdint>
namespace cg = cooperative_groups;

#define LAS __attribute__((address_space(3)))
typedef unsigned short bf16_t;
typedef short bf16x8 __attribute__((ext_vector_type(8)));
typedef short s16x4 __attribute__((ext_vector_type(4)));
typedef float f32x4 __attribute__((ext_vector_type(4)));
typedef float f32x2 __attribute__((ext_vector_type(2)));
typedef unsigned u32x4 __attribute__((ext_vector_type(4)));
typedef unsigned u32x2 __attribute__((ext_vector_type(2)));

constexpr int NTOK = 16384, DM = 1024, DIN = 10752, BW = 512, SEQ = 4096, NB = 4, DEPTH = 4, MEMLEN = 256;
constexpr int C_AU = 0, C_AV = 512, C_AG = 1024, C_PI = 1536, C_PG = 2048, C_CQ = 2560, C_CK = 4096, C_CV = 4608, C_CG = 5120, C_MQ = 5632, C_MG = 6144, C_GM = 6656;
constexpr float EPS = 1e-6f;
constexpr int NGATE = 4096, NMIX = DIN - NGATE;
__host__ __device__ constexpr bool is_fp8_tile(int pn) { return (pn >= 10 && pn < 18) || (pn >= 20 && pn < 30) || pn >= 34; }
constexpr int NT_FP8 = 26, NT_BF16 = 16;
constexpr float WG8_SCALE = 64.0f;
constexpr float QSCALE = 0.08838834764831845f * 1.4426950408889634f;

constexpr size_t MiB = 1u << 20;
constexpr size_t WS_WIN = 0, WS_WBR = 84 * MiB, WS_WOUT = 100 * MiB, WS_WKV = 108 * MiB, WS_POOLW = 116 * MiB, WS_GMWS = 116 * MiB + 512 * 1024;
constexpr size_t WS_XB = 117 * MiB, WS_MEMB = 149 * MiB, WS_MEMKV = 151 * MiB, WS_ROWSS = 159 * MiB, WS_MEMSS = 159 * MiB + 512 * 1024, WS_LSE = 160 * MiB;
constexpr size_t WS_OG = 161 * MiB, WS_ZF = 209 * MiB, WS_XB8 = 209 * MiB  , WS_WG8 = 225 * MiB  , WS_PROJ = 273 * MiB, WS_Z = 609 * MiB, WS_CTL = 641 * MiB, WS_END = 642 * MiB;
constexpr int LDS_BYTES = 147456;

__device__ __forceinline__ float bflo(unsigned w) { return __uint_as_float(w << 16); }
__device__ __forceinline__ float bfhi(unsigned w) { return __uint_as_float(w & 0xffff0000u); }
__device__ __forceinline__ unsigned cvt_pk_bf16(float lo, float hi) { unsigned r; asm("v_cvt_pk_bf16_f32 %0, %1, %2" : "=v"(r) : "v"(lo), "v"(hi)); return r; }
__device__ __forceinline__ float fast_rcp(float x) { return __builtin_amdgcn_rcpf(x); }
__device__ __forceinline__ float fast_exp2(float x) { return __builtin_amdgcn_exp2f(x); }
__device__ __forceinline__ float sigmoidf_(float x) { return fast_rcp(1.0f + fast_exp2(-1.4426950408889634f * x)); }
__device__ __forceinline__ float siluf_(float x) { return x * sigmoidf_(x); }
__device__ __forceinline__ float geluf_(float v) {
    const float av = __builtin_fabsf(v), d = av * 0.2316418882f + 1.0f, t = fast_rcp(d);
    float q = t * 0.5307027145f + (-0.7265760135f); q = q * t + 0.7107068705f; q = q * t + (-0.142248368f); q = q * t + 0.127414796f; q = q * t;
    const float e = fast_exp2((v * v) * (-0.72134752044f));
    const float m = v * (q * e), r = v - m;
    return v < 0.f ? m : r;
}
namespace pg8 {
#define PG8_LAS __attribute__((address_space(3)))
constexpr int BM = 256, BK = 64, HALF = 128, HALF_ROWS = 128, HTB = HALF * BK * 2  , STAGE_BYTES = 8 * HTB, NXCD = 8, WGM = 8;

__host__ __device__ __forceinline__ int lds_byte(int r, int c) { const int st = (r >> 4) * 2 + (c >> 5), rr = r & 15, cc = c & 31, ob = rr * 64 + cc * 2; return st * 1024 + (ob ^ (((ob >> 9) & 1) << 5)); }
__host__ __device__ __forceinline__ void stage_rc(int b, int& R, int& C) { const int st = b / 1024, sb = b % 1024, swz = sb ^ (((sb >> 9) & 1) << 5); R = (st >> 1) * 16 + swz / 64; C = (st & 1) * 32 + (swz % 64) / 2; }
__host__ __device__ __forceinline__ int perm32(int rho) { const int n = rho >> 4, i = rho & 15; return 8 * (i >> 2) + 4 * n + (i & 3); }

typedef int i32x4 __attribute__((ext_vector_type(4))); typedef int i32x8 __attribute__((ext_vector_type(8)));
__device__ __forceinline__ i32x8 cat8i(bf16x8 a, bf16x8 b) { return __builtin_shufflevector(__builtin_bit_cast(i32x4, a), __builtin_bit_cast(i32x4, b), 0, 1, 2, 3, 4, 5, 6, 7); }
struct Unit { int pm, pn, z; long aoff, boff; };
struct Gemm { const bf16_t* A; const bf16_t* Bt; int lda, ldb, K; };

struct StaticOrder {
    int nM, nN, nwg, G, c;
    __host__ __device__ void init(int M, int N, int G_, int c_) { nM = M / BM; nN = N / BM; nwg = nM * nN; G = G_; c = c_; }
    __host__ __device__ bool next(int i, Unit& u) const {
        const long L = (long)i * G + c; if (L >= nwg) return false;
        int wgid = (int)L; { const int q = nwg / NXCD, r = nwg % NXCD, xcd = wgid % NXCD, off = wgid / NXCD; wgid = (xcd < r ? xcd * (q + 1) : r * (q + 1) + (xcd - r) * q) + off; }
        const int nig = WGM * nN, gid = wgid / nig, fm = gid * WGM, gsz = (nM - fm) < WGM ? (nM - fm) : WGM;
        u.pm = fm + ((wgid % nig) % gsz); u.pn = (wgid % nig) / gsz; u.z = 0; u.aoff = 0; u.boff = 0; return true;
    }
};
__host__ __device__ __forceinline__ int fp8_tile(int j) { return j < 8 ? 10 + j : (j < 18 ? 12 + j : 16 + j); }
__host__ __device__ __forceinline__ int bf16_tile(int j) { return j < 10 ? j : (j < 12 ? 8 + j : 18 + j); }
struct ProjOrder {
    StaticOrder base; int rounds;
    __device__ bool next(int i, Unit& u) const { if (i >= rounds || !base.next(i, u)) return false; u.pn = bf16_tile(u.pn); return true; }
};
struct ProjHalfOrder {
    StaticOrder base; int round, half; long hbytes;
    __device__ bool next(int i, Unit& u) const { if (i > 0 || !base.next(round, u)) return false; u.pn = fp8_tile(u.pn); u.z = half; u.aoff = half * hbytes; return true; }
};
struct GateOrder {
    StaticOrder base; int rounds;
    __device__ bool next(int i, Unit& u) const { if (i >= rounds || !base.next(i, u)) return false; u.pn = fp8_tile(u.pn); return true; }
};
struct MergeOrder {
    StaticOrder base; long astep, bstep; long a0, a1, a2, a3;
    __device__ bool next(int i, Unit& u) const {
        if (!base.next(i >> 2, u)) return false;
        const int z = i & 3; u.z = z; u.aoff = (z == 0 ? a0 : z == 1 ? a1 : z == 2 ? a2 : a3); u.boff = bstep * z; return true;
    }
};

template <class Epi, class Sched, bool ALIGN_EPI = false, bool SP2 = false, bool HALF_M = false, bool FP8 = false>
__device__ __forceinline__ void gemm_phase(PG8_LAS unsigned char* lds, const Gemm g, const Sched& S, const Epi& E, int tid) {
    const int wid = __builtin_amdgcn_readfirstlane(tid >> 6), lane = tid & 63, wr = wid >> 2, wc = wid & 3, fr = lane & 15, fq = lane >> 4;
    const int K = g.K, nt = K / BK;
    unsigned voffA[2], voffB[2];
#pragma unroll
    for (int i = 0; i < 2; ++i) { int R, C; stage_rc(tid * 16 + i * 8192, R, C); const int Rb = Epi::PERM ? ((R & ~31) + perm32(R & 31)) : R;
        voffA[i] = (unsigned)(R * g.lda + C) * 2u; voffB[i] = (unsigned)(Rb * g.ldb + C) * 2u; }
    const size_t kstep = (size_t)(BK * 2);
    const size_t hstepA = (size_t)HALF * g.lda * 2, hstepB = (size_t)HALF * g.ldb * 2;
    const unsigned ldsw = (unsigned)wid * 1024u;
    const int aoff = lds_byte(wr * 64 + fr, fq * 8), boff = lds_byte(wc * 32 + fr, fq * 8);
#define PG8_SA(b, h) (((b) * 2 + (h)) * HTB)
#define PG8_SB(b, h) ((4 + (b) * 2 + (h)) * HTB)
#define PG8_STAGE(bufoff, gbase, voff) do { _Pragma("unroll") for (int _i = 0; _i < 2; ++_i) \
        __builtin_amdgcn_global_load_lds((const unsigned*)((const char*)(gbase) + (voff)[_i]), (PG8_LAS unsigned*)(lds + (bufoff) + ldsw + _i * 8192), 16, 0, 0); } while (0)
#define PG8_LDA(dst, b, h) do { _Pragma("unroll") for (int m = 0; m < 4; ++m) { if constexpr (FP8) dst##8[m] = cat8i(*(const PG8_LAS bf16x8*)(lds + PG8_SA(b, h) + aoff + m * 2048), *(const PG8_LAS bf16x8*)(lds + PG8_SA(b, h) + aoff + m * 2048 + 1024)); \
        else { _Pragma("unroll") for (int k = 0; k < 2; ++k) dst[m][k] = *(const PG8_LAS bf16x8*)(lds + PG8_SA(b, h) + aoff + m * 2048 + k * 1024); } } } while (0)
#define PG8_LDB(dst, b, h) do { _Pragma("unroll") for (int n = 0; n < 2; ++n) { if constexpr (FP8) dst##8[n] = cat8i(*(const PG8_LAS bf16x8*)(lds + PG8_SB(b, h) + boff + n * 2048), *(const PG8_LAS bf16x8*)(lds + PG8_SB(b, h) + boff + n * 2048 + 1024)); \
        else { _Pragma("unroll") for (int k = 0; k < 2; ++k) dst[n][k] = *(const PG8_LAS bf16x8*)(lds + PG8_SB(b, h) + boff + n * 2048 + k * 1024); } } } while (0)
#define PG8_MMA(ai, bj, At, Bt) do { __builtin_amdgcn_s_setprio(1); _Pragma("unroll") for (int m = 0; m < 4; ++m) _Pragma("unroll") for (int n = 0; n < 2; ++n) { \
        if constexpr (FP8) asm volatile("v_mfma_scale_f32_16x16x128_f8f6f4 %0, %1, %2, %0, %3, %3 op_sel_hi:[0,0,0]" : "+v"(acc[ai][bj][m][n]) : "v"(Bt##8[n]), "v"(At##8[m]), "v"(sc8));   \
        else { _Pragma("unroll") for (int k = 0; k < 2; ++k) acc[ai][bj][m][n] = __builtin_amdgcn_mfma_f32_16x16x32_bf16(Bt[n][k], At[m][k], acc[ai][bj][m][n], 0, 0, 0); } } \
        __builtin_amdgcn_s_setprio(0); } while (0)
#define PG8_WAIT_V(n) asm volatile("s_waitcnt vmcnt(" #n ")" ::: "memory")
#define PG8_WAIT_L(n) asm volatile("s_waitcnt lgkmcnt(" #n ")" ::: "memory")
#define PG8_BAR __builtin_amdgcn_s_barrier()
#define PG8_SCHED __builtin_amdgcn_sched_barrier(0)
    Unit cur, nxt; int ui = 0;
    if (!S.next(0, cur)) return;
    f32x4 acc[2][2][4][2];
#pragma unroll
    for (int a = 0; a < 2; ++a)
#pragma unroll
        for (int b = 0; b < 2; ++b)
#pragma unroll
            for (int m = 0; m < 4; ++m)
#pragma unroll
                for (int n = 0; n < 2; ++n) acc[a][b][m][n] = (f32x4){0.f, 0.f, 0.f, 0.f};
    bf16x8 At[4][2], B0[2][2], B1[2][2];
    const int sc8 = 0x7f7f7f7f;
    i32x8 At8[4], B08[2], B18[2];
    const char* cA = (const char*)g.A + (size_t)cur.pm * 2 * hstepA + cur.aoff; const char* cB = (const char*)g.Bt + (size_t)cur.pn * 2 * hstepB + cur.boff;
    if constexpr (SP2) {
        PG8_STAGE(PG8_SB(0, 0), cB, voffB); PG8_STAGE(PG8_SB(0, 1), cB + hstepB, voffB); PG8_STAGE(PG8_SA(0, 0), cA, voffA); PG8_STAGE(PG8_SA(0, 1), cA + hstepA, voffA);
        if (wr == 1) PG8_BAR;
        PG8_WAIT_V(2); PG8_BAR;
        PG8_STAGE(PG8_SB(1, 0), cB + kstep, voffB); PG8_STAGE(PG8_SA(1, 0), cA + kstep, voffA); PG8_STAGE(PG8_SB(1, 1), cB + hstepB + kstep, voffB);
        PG8_WAIT_V(6); PG8_BAR;
    } else {
        PG8_STAGE(PG8_SB(0, 0), cB, voffB); PG8_STAGE(PG8_SA(0, 0), cA, voffA); PG8_STAGE(PG8_SB(0, 1), cB + hstepB, voffB); PG8_STAGE(PG8_SA(0, 1), cA + hstepA, voffA);
        if (wr == 1) PG8_BAR;
        PG8_WAIT_V(4); PG8_BAR;
        PG8_STAGE(PG8_SB(1, 0), cB + kstep, voffB); PG8_STAGE(PG8_SA(1, 0), cA + kstep, voffA); PG8_STAGE(PG8_SB(1, 1), cB + hstepB + kstep, voffB);
        PG8_WAIT_V(6); PG8_BAR;
    }
    for (;;) {
        const bool has_next = S.next(ui + 1, nxt);
        const char* nA = has_next ? (const char*)g.A + (size_t)nxt.pm * 2 * hstepA + nxt.aoff : cA; const char* nB = has_next ? (const char*)g.Bt + (size_t)nxt.pn * 2 * hstepB + nxt.boff : cB;
        for (int t = 0; t < nt; t += 2) {
            const bool last = (t == nt - 2);
            const char* a1 = cA + (size_t)(t + 1) * kstep;
            const char* a2 = last ? nA : cA + (size_t)(t + 2) * kstep; const char* b2 = last ? nB : cB + (size_t)(t + 2) * kstep;
            const char* a3 = a2 + kstep; const char* b3 = b2 + kstep;
            if constexpr (SP2) {
            PG8_LDB(B0, 0, 0); PG8_LDB(B1, 0, 1); PG8_SCHED; PG8_LDA(At, 0, 0); PG8_STAGE(PG8_SA(1, 1), a1 + hstepA, voffA);
            PG8_WAIT_V(8); PG8_WAIT_L(0); PG8_BAR; PG8_MMA(0, 0, At, B0); PG8_MMA(0, 1, At, B1); PG8_BAR; PG8_SCHED;
            if constexpr (!HALF_M) PG8_LDA(At, 0, 1); PG8_STAGE(PG8_SB(0, 0), b2, voffB); PG8_STAGE(PG8_SB(0, 1), b2 + hstepB, voffB); PG8_STAGE(PG8_SA(0, 0), a2, voffA);
            PG8_WAIT_V(8); PG8_WAIT_L(0); PG8_BAR; if constexpr (!HALF_M) { PG8_MMA(1, 0, At, B0); PG8_MMA(1, 1, At, B1); } PG8_BAR; PG8_SCHED;
            PG8_LDB(B0, 1, 0); PG8_LDB(B1, 1, 1); PG8_SCHED; PG8_LDA(At, 1, 0); PG8_STAGE(PG8_SA(0, 1), a2 + hstepA, voffA);
            PG8_WAIT_V(8); PG8_WAIT_L(0); PG8_BAR; PG8_MMA(0, 0, At, B0); PG8_MMA(0, 1, At, B1); PG8_BAR; PG8_SCHED;
            if constexpr (!HALF_M) PG8_LDA(At, 1, 1); PG8_STAGE(PG8_SB(1, 0), b3, voffB); PG8_STAGE(PG8_SB(1, 1), b3 + hstepB, voffB); PG8_STAGE(PG8_SA(1, 0), a3, voffA);
            PG8_WAIT_V(8); PG8_WAIT_L(0); PG8_BAR; if constexpr (!HALF_M) { PG8_MMA(1, 0, At, B0); PG8_MMA(1, 1, At, B1); } PG8_BAR; PG8_SCHED;
            } else {
            PG8_LDB(B0, 0, 0); PG8_SCHED; PG8_LDA(At, 0, 0); PG8_STAGE(PG8_SA(1, 1), a1 + hstepA, voffA);
            PG8_WAIT_L(8); PG8_BAR; PG8_WAIT_L(0); PG8_MMA(0, 0, At, B0); PG8_BAR; PG8_SCHED;
            PG8_LDB(B1, 0, 1); PG8_STAGE(PG8_SB(0, 0), b2, voffB);
            PG8_BAR; PG8_WAIT_L(0); PG8_MMA(0, 1, At, B1); PG8_BAR;
            PG8_LDA(At, 0, 1); PG8_STAGE(PG8_SA(0, 0), a2, voffA);
            PG8_BAR; PG8_WAIT_L(0); PG8_MMA(1, 0, At, B0); PG8_BAR; PG8_SCHED;
            PG8_STAGE(PG8_SB(0, 1), b2 + hstepB, voffB);
            PG8_WAIT_V(6); PG8_BAR; PG8_MMA(1, 1, At, B1); PG8_BAR;
            PG8_LDB(B0, 1, 0); PG8_SCHED; PG8_LDA(At, 1, 0); PG8_STAGE(PG8_SA(0, 1), a2 + hstepA, voffA);
            PG8_WAIT_L(8); PG8_BAR; PG8_WAIT_L(0); PG8_MMA(0, 0, At, B0); PG8_BAR; PG8_SCHED;
            PG8_LDB(B1, 1, 1); PG8_STAGE(PG8_SB(1, 0), b3, voffB);
            PG8_BAR; PG8_WAIT_L(0); PG8_MMA(0, 1, At, B1); PG8_BAR;
            PG8_LDA(At, 1, 1); PG8_STAGE(PG8_SA(1, 0), a3, voffA);
            PG8_BAR; PG8_WAIT_L(0); PG8_MMA(1, 0, At, B0); PG8_BAR; PG8_SCHED;
            PG8_STAGE(PG8_SB(1, 1), b3 + hstepB, voffB);
            PG8_WAIT_V(6); PG8_BAR; PG8_MMA(1, 1, At, B1); PG8_BAR;
            }
        }
        if constexpr (ALIGN_EPI) { if (wr == 0) PG8_BAR; }
        if constexpr (FP8) asm volatile("s_nop 15\n\ts_nop 15" ::: "memory");
        E(acc, cur, wr, wc, fr, fq);
        if (!has_next) break;
#pragma unroll
        for (int a = 0; a < 2; ++a)
#pragma unroll
            for (int b = 0; b < 2; ++b)
#pragma unroll
                for (int m = 0; m < 4; ++m)
#pragma unroll
                    for (int n = 0; n < 2; ++n) acc[a][b][m][n] = (f32x4){0.f, 0.f, 0.f, 0.f};
        cur = nxt; cA = nA; cB = nB; ++ui;
        if constexpr (ALIGN_EPI) { if (wr == 1) PG8_BAR; }
    }
    PG8_WAIT_V(0);
    if constexpr (!ALIGN_EPI) { if (wr == 0) PG8_BAR; }
    PG8_BAR;
#undef PG8_SA
#undef PG8_SB
#undef PG8_STAGE
#undef PG8_LDA
#undef PG8_LDB
#undef PG8_MMA
#undef PG8_WAIT_V
#undef PG8_WAIT_L
#undef PG8_BAR
#undef PG8_SCHED
}

template <bool HM = false> struct EpiProjT {
    static constexpr bool PERM = true;
    bf16_t* O; int ldc; const float* ss; int mode; float oscale;
    __device__ __forceinline__ int act_of(int pn) const {
        if (mode) return 0;
        if (pn < 4) return 1; if (pn < 6) return 2; if (pn < 8) return 0; if (pn < 10) return 2; if (pn < 16) return 4; if (pn < 20) return 0;
        if (pn < 22) return 2; if (pn < 24) return 4; if (pn < 26) return 2; return 3;
    }
    __device__ __forceinline__ void operator()(const f32x4 (&acc)[2][2][4][2], const Unit& u, int wr, int wc, int fr, int fq) const {
        const int row0 = u.pm * BM + (HM ? u.z * HALF_ROWS : 0) + wr * 64 + fr, col0 = u.pn * BM + wc * 32 + 8 * fq; const int act = act_of(u.pn);
#pragma unroll
        for (int ai = 0; ai < (HM ? 1 : 2); ++ai)
#pragma unroll
            for (int m = 0; m < 4; ++m) { const int row = row0 + ai * HALF + m * 16; const float rs = oscale / sqrtf(ss[row] * (1.0f / 1024.0f) + EPS);
                bf16_t* rowp = O + (size_t)row * ldc + col0;
#pragma unroll
                for (int bj = 0; bj < 2; ++bj) { f32x4 v0 = acc[ai][bj][m][0] * rs, v1 = acc[ai][bj][m][1] * rs;
                    if (act == 1) { for (int e = 0; e < 4; ++e) { v0[e] = geluf_(v0[e]); v1[e] = geluf_(v1[e]); } }
                    else if (act == 2) { for (int e = 0; e < 4; ++e) { v0[e] = siluf_(v0[e]); v1[e] = siluf_(v1[e]); } }
                    else if (act == 3) {
                        unsigned q[8];
                        for (int e = 0; e < 4; ++e) { q[e] = (unsigned)(sigmoidf_(v0[e]) * 255.0f + 0.5f); q[4 + e] = (unsigned)(sigmoidf_(v1[e]) * 255.0f + 0.5f); }
                        u32x2 w8; w8.x = q[0] | (q[1] << 8) | (q[2] << 16) | (q[3] << 24); w8.y = q[4] | (q[5] << 8) | (q[6] << 16) | (q[7] << 24);
                        *(u32x2*)((unsigned char*)(O + (size_t)row * ldc + C_GM) + (col0 + bj * HALF - C_GM)) = w8; continue; }
                    else if (act == 4) { v0 = v0 * QSCALE; v1 = v1 * QSCALE; }
                    u32x4 w; w.x = cvt_pk_bf16(v0[0], v0[1]); w.y = cvt_pk_bf16(v0[2], v0[3]); w.z = cvt_pk_bf16(v1[0], v1[1]); w.w = cvt_pk_bf16(v1[2], v1[3]);
                    *(u32x4*)(rowp + bj * HALF) = w; } }
    }
};
typedef EpiProjT<false> EpiProj;
struct EpiMerge {
    static constexpr bool PERM = true;
    const bf16_t* gates; int ldg; bf16_t* Z;
    __device__ __forceinline__ void operator()(const f32x4 (&acc)[2][2][4][2], const Unit& u, int wr, int wc, int fr, int fq) const {
        const int row0 = u.pm * BM + wr * 64 + fr, col0 = u.pn * BM + wc * 32 + 8 * fq; const int z = u.z;
        const unsigned char* gbase = (const unsigned char*)(gates + (size_t)row0 * ldg) + z * DM + col0; bf16_t* zbase = Z + (size_t)row0 * DM + col0;
        u32x2 gw[8][2]; u32x4 pz[8][2];
#define EM_LOAD(s) do { const int r_ = ((s) >> 2) * HALF + ((s) & 3) * 16; _Pragma("unroll") for (int bj = 0; bj < 2; ++bj) { gw[s][bj] = *(const u32x2*)(gbase + (size_t)r_ * ldg * 2 + bj * HALF); \
            if (z > 0) pz[s][bj] = *(const u32x4*)(zbase + (size_t)r_ * DM + bj * HALF); else pz[s][bj] = (u32x4){0u, 0u, 0u, 0u}; } } while (0)
        EM_LOAD(0); EM_LOAD(1); EM_LOAD(2); asm volatile("" ::: "memory");
#pragma unroll
        for (int s = 0; s < 8; ++s) {
            if (s + 3 < 8) { EM_LOAD(s + 3); }
            asm volatile("" ::: "memory");
            const int ai = s >> 2, m = s & 3, r_ = ai * HALF + m * 16;
#pragma unroll
            for (int bj = 0; bj < 2; ++bj) { const u32x2 g = gw[s][bj]; const u32x4 q = pz[s][bj]; const float k255 = 1.0f / 255.0f;
                f32x4 v0 = acc[ai][bj][m][0] * k255, v1 = acc[ai][bj][m][1] * k255;
                v0[0] = v0[0] * (float)((g.x >> 0) & 0xffu) + bflo(q.x); v0[1] = v0[1] * (float)((g.x >> 8) & 0xffu) + bfhi(q.x); v0[2] = v0[2] * (float)((g.x >> 16) & 0xffu) + bflo(q.y); v0[3] = v0[3] * (float)((g.x >> 24) & 0xffu) + bfhi(q.y);
                v1[0] = v1[0] * (float)((g.y >> 0) & 0xffu) + bflo(q.z); v1[1] = v1[1] * (float)((g.y >> 8) & 0xffu) + bfhi(q.z); v1[2] = v1[2] * (float)((g.y >> 16) & 0xffu) + bflo(q.w); v1[3] = v1[3] * (float)((g.y >> 24) & 0xffu) + bfhi(q.w);
                u32x4 w; w.x = cvt_pk_bf16(v0[0], v0[1]); w.y = cvt_pk_bf16(v0[2], v0[3]); w.z = cvt_pk_bf16(v1[0], v1[1]); w.w = cvt_pk_bf16(v1[2], v1[3]);
                *(u32x4*)(zbase + (size_t)r_ * DM + bj * HALF) = w; }
            asm volatile("" ::: "memory");
        }
#undef EM_LOAD
    }
};
struct EpiOut {
    static constexpr bool PERM = true;
    const float* xi; float* xo; bf16_t* xb; float* ssn; unsigned char* xb8; int wr_xb;
    __device__ __forceinline__ void operator()(const f32x4 (&acc)[2][2][4][2], const Unit& u, int wr, int wc, int fr, int fq) const {
        const int row0 = u.pm * BM + wr * 64 + fr, col0 = u.pn * BM + wc * 32 + 8 * fq;
        const size_t base = (size_t)row0 * DM + col0;
        f32x4 xv[8][2][2];
#define EO_LOAD(s) do { const size_t o_ = base + (size_t)(((s) >> 2) * HALF + ((s) & 3) * 16) * DM; _Pragma("unroll") for (int bj = 0; bj < 2; ++bj) { \
            xv[s][bj][0] = *(const f32x4*)(xi + o_ + bj * HALF); xv[s][bj][1] = *(const f32x4*)(xi + o_ + bj * HALF + 4); } } while (0)
        EO_LOAD(0); EO_LOAD(1); EO_LOAD(2); asm volatile("" ::: "memory");
#pragma unroll
        for (int s = 0; s < 8; ++s) {
            if (s + 3 < 8) { EO_LOAD(s + 3); }
            asm volatile("" ::: "memory");
            const int ai = s >> 2, m = s & 3; const size_t o_ = base + (size_t)(ai * HALF + m * 16) * DM; float sq = 0.f;
#pragma unroll
            for (int bj = 0; bj < 2; ++bj) { const f32x4 v0 = xv[s][bj][0] + acc[ai][bj][m][0], v1 = xv[s][bj][1] + acc[ai][bj][m][1];
                *(f32x4*)(xo + o_ + bj * HALF) = v0; *(f32x4*)(xo + o_ + bj * HALF + 4) = v1;
                u32x4 w; w.x = cvt_pk_bf16(v0[0], v0[1]); w.y = cvt_pk_bf16(v0[2], v0[3]); w.z = cvt_pk_bf16(v1[0], v1[1]); w.w = cvt_pk_bf16(v1[2], v1[3]);
                if (wr_xb) { *(u32x4*)(xb + o_ + bj * HALF) = w;
                  u32x2 w8; int t8 = 0; t8 = __builtin_amdgcn_cvt_pk_fp8_f32(v0[0], v0[1], t8, false); t8 = __builtin_amdgcn_cvt_pk_fp8_f32(v0[2], v0[3], t8, true); w8.x = (unsigned)t8;
                  t8 = 0; t8 = __builtin_amdgcn_cvt_pk_fp8_f32(v1[0], v1[1], t8, false); t8 = __builtin_amdgcn_cvt_pk_fp8_f32(v1[2], v1[3], t8, true); w8.y = (unsigned)t8; *(u32x2*)(xb8 + o_ + bj * HALF) = w8; }
                sq += (v0[0] * v0[0] + v0[1] * v0[1]) + (v0[2] * v0[2] + v0[3] * v0[3]) + (v1[0] * v1[0] + v1[1] * v1[1]) + (v1[2] * v1[2] + v1[3] * v1[3]); }
            sq += __shfl_xor(sq, 16); sq += __shfl_xor(sq, 32);
            if (fq == 0) atomicAdd(ssn + row0 + ai * HALF + m * 16, sq);
            asm volatile("" ::: "memory");
        }
#undef EO_LOAD
    }
};
}
struct Params {
    const float *x, *mem, *norm_g, *w_in, *gm_ln_g, *gm_ln_b, *gm_ws, *gm_bs, *pool_w, *pool_scale, *mem_norm_g, *w_mem_kv, *w_branch, *w_out, *final_norm_g;
    float* out; unsigned char* ws;
};
constexpr int NWAVES = 8, NTHREADS = 512;
#define LDS_WAIT() asm volatile("s_waitcnt lgkmcnt(0)" ::: "memory")

__device__ __forceinline__ float wave_sum(float v) {
#pragma unroll
    for (int o = 1; o < 64; o <<= 1) v += __shfl_xor(v, o);
    return v;
}
__device__ __forceinline__ s16x4 vtr(const LAS unsigned char* p) { return __builtin_bit_cast(s16x4, __builtin_amdgcn_ds_read_tr16_b64_v4i16((LAS s16x4*)p)); }
__device__ __forceinline__ bf16x8 cat8(s16x4 a, s16x4 b) { return __builtin_shufflevector(a, b, 0, 1, 2, 3, 4, 5, 6, 7); }

template <bool F8 = false> __device__ __forceinline__ void p0_transpose_item(const float* W, int K, int N, bf16_t* WT, const float* ks, LAS float* scr, int item, int lane, unsigned char* WT8 = nullptr, int n8 = 0, float s8 = 1.f) {
    const int nblk = N / 64, kb = item / nblk, nb = item % nblk, k0 = 64 * kb, n0 = 64 * nb;
    const int lr = lane >> 4, lc = (lane & 15) * 4;
    f32x4 v[16];
#pragma unroll
    for (int i = 0; i < 16; ++i) v[i] = *(const f32x4*)(W + (size_t)(k0 + 4 * i + lr) * N + n0 + lc);
#pragma unroll
    for (int i = 0; i < 16; ++i) { const int k = 4 * i + lr; const float sc = ks ? ks[k0 + k] : 1.0f;
        *(LAS f32x4*)(scr + k * 64 + (lc ^ (4 * ((k >> 3) & 7)))) = v[i] * sc; }
    LDS_WAIT(); asm volatile("" ::: "memory");
    const int c = lane & 7;
#pragma unroll
    for (int j = 0; j < 8; ++j) { const int n = (lane >> 3) + 8 * j; const LAS float* s = scr + (8 * c) * 64 + (n ^ (4 * c));
        u32x4 o; o.x = cvt_pk_bf16(s[0 * 64], s[1 * 64]); o.y = cvt_pk_bf16(s[2 * 64], s[3 * 64]); o.z = cvt_pk_bf16(s[4 * 64], s[5 * 64]); o.w = cvt_pk_bf16(s[6 * 64], s[7 * 64]);
        if (F8 && is_fp8_tile(n0 >> 8)) { u32x2 o8; int t8 = 0; t8 = __builtin_amdgcn_cvt_pk_fp8_f32(s[0 * 64] * s8, s[1 * 64] * s8, t8, false); t8 = __builtin_amdgcn_cvt_pk_fp8_f32(s[2 * 64] * s8, s[3 * 64] * s8, t8, true); o8.x = (unsigned)t8;
            t8 = 0; t8 = __builtin_amdgcn_cvt_pk_fp8_f32(s[4 * 64] * s8, s[5 * 64] * s8, t8, false); t8 = __builtin_amdgcn_cvt_pk_fp8_f32(s[6 * 64] * s8, s[7 * 64] * s8, t8, true); o8.y = (unsigned)t8;
            *(u32x2*)(WT8 + (size_t)(n0 + n) * K + k0 + 8 * c) = o8; }
        else *(u32x4*)(WT + (size_t)(n0 + n) * K + k0 + 8 * c) = o; }
    LDS_WAIT(); asm volatile("" ::: "memory");
}
__device__ __forceinline__ void row_to_bf16(const float* xrow, bf16_t* orow, float* ssp, int lane, unsigned char* o8row = nullptr) {
    const f32x4* xr = (const f32x4*)xrow + lane;
    f32x4 v[4]; float s = 0.f;
#pragma unroll
    for (int j = 0; j < 4; ++j) { v[j] = xr[64 * j]; s += (v[j].x * v[j].x + v[j].y * v[j].y) + (v[j].z * v[j].z + v[j].w * v[j].w); }
    s = wave_sum(s);
    u32x2* o8 = (u32x2*)orow + lane;
#pragma unroll
    for (int j = 0; j < 4; ++j) { u32x2 w; w.x = cvt_pk_bf16(v[j].x, v[j].y); w.y = cvt_pk_bf16(v[j].z, v[j].w); o8[64 * j] = w; }
    if (o8row) { unsigned* o4 = (unsigned*)o8row + lane;
#pragma unroll
        for (int j = 0; j < 4; ++j) { int t8 = 0; t8 = __builtin_amdgcn_cvt_pk_fp8_f32(v[j].x, v[j].y, t8, false); t8 = __builtin_amdgcn_cvt_pk_fp8_f32(v[j].z, v[j].w, t8, true); o4[64 * j] = (unsigned)t8; } }
    if (lane == 0) *ssp = s;
}

__device__ __forceinline__ void prologue(const Params& p, LAS unsigned char* lds, int vcu, int G, int wave, int lane) {
    unsigned char* ws = p.ws;
    LAS float* scr = (LAS float*)(lds + wave * 16384);
    const int gw = vcu * NWAVES + wave, NGW = G * NWAVES;
    constexpr int I_IN = (DM / 64) * (DIN / 64);
    constexpr int I_BR = (BW / 64) * (DM / 64);
    constexpr int I_SQ = (DM / 64) * (DM / 64);
    constexpr int I_PW = (128 / 64) * (128 / 64);
    constexpr int N_IN = DEPTH * I_IN, N_BR = DEPTH * 4 * I_BR, N_SQ = DEPTH * I_SQ, N_PW = DEPTH * 4 * I_PW;
    constexpr int NITEMS = N_IN + N_BR + 2 * N_SQ + N_PW;
    for (int it = gw; it < NITEMS; it += NGW) {
        int r = it;
        if (r < N_IN) { const int l = r / I_IN; p0_transpose_item<true>(p.w_in + (size_t)l * DM * DIN, DM, DIN, (bf16_t*)(ws + WS_WIN) + (size_t)l * DIN * DM, p.norm_g + l * DM, scr, r % I_IN, lane, ws + WS_WG8 + (size_t)l * DIN * DM, 0, WG8_SCALE); continue; } r -= N_IN;
        if (r < N_BR) { const int lb = r / I_BR; p0_transpose_item(p.w_branch + (size_t)lb * BW * DM, BW, DM, (bf16_t*)(ws + WS_WBR) + (size_t)lb * DM * BW, nullptr, scr, r % I_BR, lane); continue; } r -= N_BR;
        if (r < N_SQ) { const int l = r / I_SQ; p0_transpose_item(p.w_out + (size_t)l * DM * DM, DM, DM, (bf16_t*)(ws + WS_WOUT) + (size_t)l * DM * DM, nullptr, scr, r % I_SQ, lane); continue; } r -= N_SQ;
        if (r < N_SQ) { const int l = r / I_SQ; p0_transpose_item(p.w_mem_kv + (size_t)l * DM * DM, DM, DM, (bf16_t*)(ws + WS_WKV) + (size_t)l * DM * DM, p.mem_norm_g + l * DM, scr, r % I_SQ, lane); continue; } r -= N_SQ;
        { const int lg = r / I_PW; p0_transpose_item(p.pool_w + (size_t)lg * 128 * 128, 128, 128, (bf16_t*)(ws + WS_POOLW) + (size_t)lg * 128 * 128, nullptr, scr, r % I_PW, lane); }
    }
    { const int gt = gw * 64 + lane, NGT = NGW * 64; bf16_t* o = (bf16_t*)(ws + WS_GMWS);
      for (int i = gt; i < DEPTH * 4 * 128 * 128 / 2; i += NGT) { const int e = 2 * i, s = e & 127, t = (e >> 7) & 127; const f32x2 v = *(const f32x2*)(p.gm_ws + e);
          ((unsigned*)o)[i] = cvt_pk_bf16(s <= t ? v.x : 0.f, (s + 1) <= t ? v.y : 0.f); }
      float* ss = (float*)(ws + WS_ROWSS);
      for (int i = gt; i < 4 * NTOK; i += NGT) ss[NTOK + i] = 0.f; }
    for (int m = gw; m < NTOK; m += 2 * NGW) {
        const int m1 = (m + NGW < NTOK) ? m + NGW : m;
        const f32x4* xa = (const f32x4*)(p.x + (size_t)m * DM) + lane; const f32x4* xb_ = (const f32x4*)(p.x + (size_t)m1 * DM) + lane;
        f32x4 va[4], vb[4]; float sa = 0.f, sb = 0.f;
#pragma unroll
        for (int j = 0; j < 4; ++j) { va[j] = xa[64 * j]; vb[j] = xb_[64 * j]; }
#pragma unroll
        for (int j = 0; j < 4; ++j) { sa += (va[j].x * va[j].x + va[j].y * va[j].y) + (va[j].z * va[j].z + va[j].w * va[j].w); sb += (vb[j].x * vb[j].x + vb[j].y * vb[j].y) + (vb[j].z * vb[j].z + vb[j].w * vb[j].w); }
#pragma unroll
        for (int o = 1; o < 64; o <<= 1) { sa += __shfl_xor(sa, o); sb += __shfl_xor(sb, o); }
        u32x2* oa = (u32x2*)((bf16_t*)(ws + WS_XB) + (size_t)m * DM) + lane; u32x2* ob = (u32x2*)((bf16_t*)(ws + WS_XB) + (size_t)m1 * DM) + lane;
        unsigned* qa = (unsigned*)(ws + WS_XB8 + (size_t)m * DM) + lane; unsigned* qb = (unsigned*)(ws + WS_XB8 + (size_t)m1 * DM) + lane;
#pragma unroll
        for (int j = 0; j < 4; ++j) { u32x2 w; w.x = cvt_pk_bf16(va[j].x, va[j].y); w.y = cvt_pk_bf16(va[j].z, va[j].w); oa[64 * j] = w; w.x = cvt_pk_bf16(vb[j].x, vb[j].y); w.y = cvt_pk_bf16(vb[j].z, vb[j].w); ob[64 * j] = w;
            int t8 = 0; t8 = __builtin_amdgcn_cvt_pk_fp8_f32(va[j].x, va[j].y, t8, false); t8 = __builtin_amdgcn_cvt_pk_fp8_f32(va[j].z, va[j].w, t8, true); qa[64 * j] = (unsigned)t8;
            t8 = 0; t8 = __builtin_amdgcn_cvt_pk_fp8_f32(vb[j].x, vb[j].y, t8, false); t8 = __builtin_amdgcn_cvt_pk_fp8_f32(vb[j].z, vb[j].w, t8, true); qb[64 * j] = (unsigned)t8; }
        if (lane == 0) { ((float*)(ws + WS_ROWSS))[m] = sa; ((float*)(ws + WS_ROWSS))[m1] = sb; }
    }
    for (int m = gw; m < NB * MEMLEN; m += NGW) row_to_bf16(p.mem + (size_t)m * DM, (bf16_t*)(ws + WS_MEMB) + (size_t)m * DM, (float*)(ws + WS_MEMSS) + m, lane);
}

constexpr int KP = 272, VP = 288;
constexpr int ATT_V_OFF = 256 * KP;
struct AttnCtx { int h, n, dil, tq0, tk0; const bf16_t *Kb, *Vb, *Qb; size_t kvp; };
template <int kind> __device__ __forceinline__ AttnCtx attn_decode(const Params& p, int l, int idx) {
    bf16_t* proj = (bf16_t*)(p.ws + WS_PROJ);
    AttnCtx c; c.h = idx & 3; const int rest = idx >> 2; c.dil = 1; c.n = 0;
    if (kind < 3) {
        c.dil = (kind == 0) ? 1 : (kind == 1 ? 4 : 16); const int nb = 32 / c.dil;
        c.n = rest % nb; const int r = (rest / nb) % c.dil, b = rest / (nb * c.dil);
        c.tq0 = b * SEQ + (c.n * 128) * c.dil + r;
        c.tk0 = b * SEQ + ((c.n - 1) * 128) * c.dil + r;
        c.Kb = proj + C_CK + c.h * 128; c.Vb = proj + C_CV + c.h * 128; c.kvp = DIN; c.Qb = proj + C_CQ + kind * BW + c.h * 128;
    } else {
        const int b = rest >> 5; c.tq0 = rest * 128; c.tk0 = b * MEMLEN;
        const bf16_t* kv = (const bf16_t*)(p.ws + WS_MEMKV) + l * DM + c.h * 128; c.Kb = kv; c.Vb = kv + BW; c.kvp = DEPTH * DM; c.Qb = proj + C_MQ + c.h * 128;
    }
    return c;
}
template <int kind> __device__ __forceinline__ void attn_issue(const Params& p, int l, int idx, int tid, int wave, int lane, u32x4 (&kreg)[8], u32x4 (&vreg)[8], bf16x8 (&qf)[4]) {
    const AttnCtx c = attn_decode<kind>(p, l, idx);
    const int ch = tid & 15, r0 = tid >> 4, fr = lane & 15, fq = lane >> 4;
#pragma unroll
    for (int i = 0; i < 8; ++i) { const int j = r0 + 32 * i; int tok = c.tk0 + j * c.dil; if (kind < 3 && c.n == 0 && j < 128) tok = c.tq0;
        kreg[i] = *(const u32x4*)(c.Kb + (size_t)tok * c.kvp + ch * 8); vreg[i] = *(const u32x4*)(c.Vb + (size_t)tok * c.kvp + ch * 8); }
    const size_t qtok = (size_t)(c.tq0 + (16 * wave + fr) * c.dil);
#pragma unroll
    for (int ks = 0; ks < 4; ++ks) qf[ks] = *(const bf16x8*)(c.Qb + qtok * DIN + 32 * ks + 8 * fq);
    asm volatile("" ::: "memory");
}
__device__ __forceinline__ void attn_stage(LAS unsigned char* lds, int tid, const u32x4 (&kreg)[8], const u32x4 (&vreg)[8]) {
    const int ch = tid & 15, r0 = tid >> 4;
#pragma unroll
    for (int i = 0; i < 8; ++i) { const int j = r0 + 32 * i;
        *(LAS u32x4*)(lds + j * KP + ch * 16) = kreg[i]; *(LAS u32x4*)(lds + ATT_V_OFF + j * VP + ch * 16) = vreg[i]; }
    __syncthreads();
}
template <int kind> __device__ __forceinline__ void attn_compute(const Params& p, int l, int idx, LAS unsigned char* lds, int wave, int lane, const bf16x8 (&qf)[4]) {
    bf16_t* proj = (bf16_t*)(p.ws + WS_PROJ);
    const AttnCtx c = attn_decode<kind>(p, l, idx);
    const int h = c.h, n = c.n, dil = c.dil;
    const int fr = lane & 15, fq = lane >> 4;
    const int qi = 16 * wave + fr; const size_t qtok = (size_t)(c.tq0 + qi * dil);
    u32x2 mg[8];
    if (kind == 3) { const bf16_t* gp0 = proj + qtok * DIN + C_MG + h * 128 + 4 * fq;
#pragma unroll
        for (int dt = 0; dt < 8; ++dt) mg[dt] = *(const u32x2*)(gp0 + 16 * dt); }
    const int tlo = (kind < 3) ? wave : 0, thi = (kind < 3) ? wave + 8 : 15;
    f32x4 s[16];
#pragma unroll
    for (int t = 0; t < 16; ++t) { s[t] = (f32x4){0.f, 0.f, 0.f, 0.f};
        if (t >= tlo && t <= thi) {
#pragma unroll
        for (int ks = 0; ks < 4; ++ks) { const bf16x8 kf = *(const LAS bf16x8*)(lds + (16 * t + fr) * KP + (32 * ks + 8 * fq) * 2);
            s[t] = __builtin_amdgcn_mfma_f32_16x16x32_bf16(kf, qf[ks], s[t], 0, 0, 0); } } }
    if (kind < 3) {
        const int jlo = (n == 0) ? (qi > 128 ? qi : 128) : qi, jhi = qi + 128;
#pragma unroll
        for (int t = 0; t < 16; ++t)
#pragma unroll
            for (int e = 0; e < 4; ++e) { const int j = 16 * t + 4 * fq + e; if (j < jlo || j > jhi) s[t][e] = -1e30f; }
    }
    float mx = -3e38f;
#pragma unroll
    for (int t = 0; t < 16; ++t) mx = fmaxf(fmaxf(fmaxf(s[t][0], s[t][1]), fmaxf(s[t][2], s[t][3])), mx);
    mx = fmaxf(mx, __shfl_xor(mx, 16)); mx = fmaxf(mx, __shfl_xor(mx, 32));
    float sum = 0.f;
#pragma unroll
    for (int t = 0; t < 16; ++t)
#pragma unroll
        for (int e = 0; e < 4; ++e) { const float pe = fast_exp2(s[t][e] - mx); s[t][e] = pe; sum += pe; }
    sum += __shfl_xor(sum, 16); sum += __shfl_xor(sum, 32);
    f32x4 o[8];
#pragma unroll
    for (int dt = 0; dt < 8; ++dt) o[dt] = (f32x4){0.f, 0.f, 0.f, 0.f};
    const LAS unsigned char* vbase = lds + ATT_V_OFF + (4 * fq + (fr >> 2)) * VP + (fr & 3) * 8;
#pragma unroll
    for (int j = 0; j < 8; ++j) {
        u32x4 pw; pw.x = cvt_pk_bf16(s[2 * j][0], s[2 * j][1]); pw.y = cvt_pk_bf16(s[2 * j][2], s[2 * j][3]); pw.z = cvt_pk_bf16(s[2 * j + 1][0], s[2 * j + 1][1]); pw.w = cvt_pk_bf16(s[2 * j + 1][2], s[2 * j + 1][3]);
        const bf16x8 pf = __builtin_bit_cast(bf16x8, pw);
        if (2 * j + 1 >= tlo && 2 * j <= thi)
#pragma unroll
        for (int dt = 0; dt < 8; ++dt) { const s16x4 v0 = vtr(vbase + (32 * j) * VP + dt * 32), v1 = vtr(vbase + (32 * j + 16) * VP + dt * 32);
            o[dt] = __builtin_amdgcn_mfma_f32_16x16x32_bf16(cat8(v0, v1), pf, o[dt], 0, 0, 0); }
    }
    const float inv = fast_rcp(sum);
    if (kind < 3) {
        bf16_t* og = (bf16_t*)(p.ws + WS_OG) + ((size_t)kind * NTOK + qtok) * BW + h * 128 + 4 * fq;
#pragma unroll
        for (int dt = 0; dt < 8; ++dt) { u32x2 w; w.x = cvt_pk_bf16(o[dt][0] * inv, o[dt][1] * inv); w.y = cvt_pk_bf16(o[dt][2] * inv, o[dt][3] * inv); *(u32x2*)(og + 16 * dt) = w; }
        if (fq == 0) ((float*)(p.ws + WS_LSE))[((size_t)kind * 512 + idx) * 128 + qi] = mx + __builtin_amdgcn_logf(sum);
    } else {
        bf16_t* gp = proj + qtok * DIN + C_MG + h * 128 + 4 * fq;
#pragma unroll
        for (int dt = 0; dt < 8; ++dt) { const u32x2 g = mg[dt]; u32x2 w;
            w.x = cvt_pk_bf16(o[dt][0] * inv * bflo(g.x), o[dt][1] * inv * bfhi(g.x)); w.y = cvt_pk_bf16(o[dt][2] * inv * bflo(g.y), o[dt][3] * inv * bfhi(g.y)); *(u32x2*)(gp + 16 * dt) = w; }
    }
    __syncthreads();
}

template <int kind> __device__ __forceinline__ void attn_item(const Params& p, int l, int idx, LAS unsigned char* lds, int tid, int wave, int lane) {
    u32x4 kreg[8], vreg[8]; bf16x8 qf[4];
    attn_issue<kind>(p, l, idx, tid, wave, lane, kreg, vreg, qf);
    attn_stage(lds, tid, kreg, vreg);
    attn_compute<kind>(p, l, idx, lds, wave, lane, qf);
}

__device__ __forceinline__ void gmlp_item(const Params& p, int l, int idx, LAS unsigned char* lds, int tid, int wave, int lane) {
    bf16_t* proj = (bf16_t*)(p.ws + WS_PROJ);
    const int h = idx & 3, c = idx >> 2, t0 = c * 128;
    const int fr = lane & 15, fq = lane >> 4;
    {
        const int lg = lane >> 4, lc = lane & 15;
        const bf16_t* vbase = proj + (size_t)(t0 + 16 * wave + lg) * DIN + C_AV + lc * 8;
        u32x4 wv[4][4];
#pragma unroll
        for (int tg = 0; tg < 4; ++tg)
#pragma unroll
            for (int q = 0; q < 4; ++q) wv[tg][q] = *(const u32x4*)(vbase + (size_t)(4 * tg) * DIN + q * 128);
        const float* lgp = p.gm_ln_g + l * BW + h * 128 + lc * 8; const float* lbp = p.gm_ln_b + l * BW + h * 128 + lc * 8;
        const f32x4 g0 = *(const f32x4*)lgp, g1 = *(const f32x4*)(lgp + 4), b0 = *(const f32x4*)lbp, b1 = *(const f32x4*)(lbp + 4);
#pragma unroll
        for (int tg = 0; tg < 4; ++tg) {
            float s1 = 0.f, s2 = 0.f;
#pragma unroll
            for (int q = 0; q < 4; ++q) { const u32x4 w = wv[tg][q];
                const float a0 = bflo(w.x), a1 = bfhi(w.x), a2 = bflo(w.y), a3 = bfhi(w.y), a4 = bflo(w.z), a5 = bfhi(w.z), a6 = bflo(w.w), a7 = bfhi(w.w);
                s1 += ((a0 + a1) + (a2 + a3)) + ((a4 + a5) + (a6 + a7)); s2 += ((a0 * a0 + a1 * a1) + (a2 * a2 + a3 * a3)) + ((a4 * a4 + a5 * a5) + (a6 * a6 + a7 * a7)); }
#pragma unroll
            for (int o = 1; o < 16; o <<= 1) { s1 += __shfl_xor(s1, o); s2 += __shfl_xor(s2, o); }
            const float mean = s1 * (1.0f / 512.0f), var = fmaxf(s2 * (1.0f / 512.0f) - mean * mean, 0.f), rstd = 1.0f / sqrtf(var + EPS);
            const u32x4 w = (h == 0) ? wv[tg][0] : (h == 1) ? wv[tg][1] : (h == 2) ? wv[tg][2] : wv[tg][3];
            u32x4 o; o.x = cvt_pk_bf16((bflo(w.x) - mean) * rstd * g0[0] + b0[0], (bfhi(w.x) - mean) * rstd * g0[1] + b0[1]);
            o.y = cvt_pk_bf16((bflo(w.y) - mean) * rstd * g0[2] + b0[2], (bfhi(w.y) - mean) * rstd * g0[3] + b0[3]);
            o.z = cvt_pk_bf16((bflo(w.z) - mean) * rstd * g1[0] + b1[0], (bfhi(w.z) - mean) * rstd * g1[1] + b1[1]);
            o.w = cvt_pk_bf16((bflo(w.w) - mean) * rstd * g1[2] + b1[2], (bfhi(w.w) - mean) * rstd * g1[3] + b1[3]);
            *(LAS u32x4*)(lds + (16 * wave + 4 * tg + lg) * VP + lc * 16) = o; }
    }
    const int tt = 16 * wave + fr; const bf16_t* wsr = (const bf16_t*)(p.ws + WS_GMWS) + ((size_t)(l * 4 + h) * 128 + tt) * 128 + 8 * fq;
    const int jn = (wave >> 1) + 1;
    bf16x8 wf[4];
#pragma unroll
    for (int j = 0; j < 4; ++j) wf[j] = *(const bf16x8*)(wsr + 32 * j);
    bf16_t* up = proj + (size_t)(t0 + tt) * DIN + C_AU + h * 128 + 4 * fq; const bf16_t* gp = up + (C_AG - C_AU);
    u32x2 uu[8], gg[8];
#pragma unroll
    for (int et = 0; et < 8; ++et) { uu[et] = *(const u32x2*)(up + 16 * et); gg[et] = *(const u32x2*)(gp + 16 * et); }
    const float bs = p.gm_bs[(l * 4 + h) * 128 + tt];
    __syncthreads();
    f32x4 d[8];
#pragma unroll
    for (int et = 0; et < 8; ++et) d[et] = (f32x4){0.f, 0.f, 0.f, 0.f};
    const LAS unsigned char* vb = lds + (8 * fq + (fr >> 2)) * VP + (fr & 3) * 8;
#pragma unroll
    for (int j = 0; j < 4; ++j) { if (j < jn) {
#pragma unroll
        for (int et = 0; et < 8; ++et) { const s16x4 v0 = vtr(vb + (32 * j) * VP + et * 32), v1 = vtr(vb + (32 * j + 4) * VP + et * 32);
            d[et] = __builtin_amdgcn_mfma_f32_16x16x32_bf16(cat8(v0, v1), wf[j], d[et], 0, 0, 0); } } }
#pragma unroll
    for (int et = 0; et < 8; ++et) { const u32x2 u = uu[et], g = gg[et]; u32x2 w;
        w.x = cvt_pk_bf16(bflo(u.x) * (d[et][0] + bs) * bflo(g.x), bfhi(u.x) * (d[et][1] + bs) * bfhi(g.x));
        w.y = cvt_pk_bf16(bflo(u.y) * (d[et][2] + bs) * bflo(g.y), bfhi(u.y) * (d[et][3] + bs) * bfhi(g.y)); *(u32x2*)(up + 16 * et) = w; }
    __syncthreads();
}

constexpr int POOL_D_OFF = 40960;
__device__ __forceinline__ void pool_item(const Params& p, int l, int idx, LAS unsigned char* lds, int tid, int wave, int lane) {
    bf16_t* proj = (bf16_t*)(p.ws + WS_PROJ);
    const int g = idx & 3, c = idx >> 2, t0 = c * 128, win = 2 << g, pos0 = t0 & (SEQ - 1);
    const int fr = lane & 15, fq = lane >> 4;
    const bf16_t* wt = (const bf16_t*)(p.ws + WS_POOLW) + (size_t)(l * 4 + g) * 128 * 128 + fr * 128 + 8 * fq;
    bf16x8 wfr[8][4];
#pragma unroll
    for (int ot = 0; ot < 8; ++ot)
#pragma unroll
        for (int j = 0; j < 4; ++j) wfr[ot][j] = *(const bf16x8*)(wt + (size_t)(16 * ot) * 128 + 32 * j);
    {
        const bf16_t* pin = proj + C_PI + g * 128;
#pragma unroll
        for (int k = 0; k < 5; ++k) { const int cidx = tid + k * NTHREADS; if (cidx < 143 * 16) { const int rr = cidx >> 4, ch = cidx & 15;
            u32x4 w = (u32x4){0u, 0u, 0u, 0u}; if (pos0 - 15 + rr >= 0) w = *(const u32x4*)(pin + (size_t)(t0 - 15 + rr) * DIN + ch * 8);
            *(LAS u32x4*)(lds + rr * KP + ch * 16) = w; } }
    }
    __syncthreads();
    {
        const int t = tid >> 2, part = tid & 3, pos = pos0 + t; const int cnt = (pos + 1 < win) ? pos + 1 : win;
        float a[32];
#pragma unroll
        for (int i = 0; i < 32; ++i) a[i] = 0.f;
        const LAS unsigned char* rp = lds + (t + 15) * KP + part * 64;
        for (int jj = 0; jj < win; ++jj) {
#pragma unroll
            for (int i = 0; i < 4; ++i) { const u32x4 w = *(const LAS u32x4*)(rp - jj * KP + i * 16);
                a[i * 8 + 0] += bflo(w.x); a[i * 8 + 1] += bfhi(w.x); a[i * 8 + 2] += bflo(w.y); a[i * 8 + 3] += bfhi(w.y); a[i * 8 + 4] += bflo(w.z); a[i * 8 + 5] += bfhi(w.z); a[i * 8 + 6] += bflo(w.w); a[i * 8 + 7] += bfhi(w.w); } }
        const float ic = 1.0f / (float)cnt;
#pragma unroll
        for (int i = 0; i < 4; ++i) { const u32x4 w = *(const LAS u32x4*)(rp + i * 16); u32x4 o;
            o.x = cvt_pk_bf16(a[i * 8 + 0] * ic - bflo(w.x), a[i * 8 + 1] * ic - bfhi(w.x)); o.y = cvt_pk_bf16(a[i * 8 + 2] * ic - bflo(w.y), a[i * 8 + 3] * ic - bfhi(w.y));
            o.z = cvt_pk_bf16(a[i * 8 + 4] * ic - bflo(w.z), a[i * 8 + 5] * ic - bfhi(w.z)); o.w = cvt_pk_bf16(a[i * 8 + 6] * ic - bflo(w.w), a[i * 8 + 7] * ic - bfhi(w.w));
            *(LAS u32x4*)(lds + POOL_D_OFF + t * KP + (part * 32 + i * 8) * 2) = o; }
    }
    __syncthreads();
    const int tt = 16 * wave + fr;
    bf16x8 df[4];
#pragma unroll
    for (int j = 0; j < 4; ++j) df[j] = *(const LAS bf16x8*)(lds + POOL_D_OFF + tt * KP + (32 * j + 8 * fq) * 2);
    const float* sc = p.pool_scale + l * BW + g * 128 + 4 * fq;
    bf16_t* gp = proj + (size_t)(t0 + tt) * DIN + C_PG + g * 128 + 4 * fq;
    u32x2 gtv[8];
#pragma unroll
    for (int ot = 0; ot < 8; ++ot) gtv[ot] = *(const u32x2*)(gp + 16 * ot);
    asm volatile("" ::: "memory");
#pragma unroll
    for (int ot = 0; ot < 8; ++ot) {
        f32x4 d = (f32x4){0.f, 0.f, 0.f, 0.f};
#pragma unroll
        for (int j = 0; j < 4; ++j) d = __builtin_amdgcn_mfma_f32_16x16x32_bf16(wfr[ot][j], df[j], d, 0, 0, 0);
        const f32x4 s4 = *(const f32x4*)(sc + 16 * ot); const u32x2 gt = gtv[ot]; u32x2 w;
        w.x = cvt_pk_bf16(d[0] * s4[0] * bflo(gt.x), d[1] * s4[1] * bfhi(gt.x)); w.y = cvt_pk_bf16(d[2] * s4[2] * bflo(gt.y), d[3] * s4[3] * bfhi(gt.y));
        *(u32x2*)(gp + 16 * ot) = w;
    }
    __syncthreads();
}

__device__ __forceinline__ void combine_phase(const Params& p, int gtid, int ngt) {
    bf16_t* proj = (bf16_t*)(p.ws + WS_PROJ); const bf16_t* og = (const bf16_t*)(p.ws + WS_OG); const float* lse = (const float*)(p.ws + WS_LSE);
    for (int i0 = gtid; i0 < NTOK * 64; i0 += 8 * ngt) {
        float l0[8], l1[8], l2[8]; u32x4 o0[8], o1[8], o2[8], g[8];
#pragma unroll
        for (int k = 0; k < 8; ++k) { int i = i0 + k * ngt; if (i >= NTOK * 64) i = i0; const int t = i >> 6, ch = (i & 63) * 8, h = ch >> 7;
            const int b = t >> 12, pos = t & (SEQ - 1);
            l0[k] = lse[((size_t)(0 * 512) + ((b * 32 + (pos >> 7)) * 4 + h)) * 128 + (pos & 127)];
            l1[k] = lse[((size_t)(1 * 512) + (((b * 4 + (pos & 3)) * 8 + (pos >> 9)) * 4 + h)) * 128 + ((pos >> 2) & 127)];
            l2[k] = lse[((size_t)(2 * 512) + (((b * 16 + (pos & 15)) * 2 + (pos >> 11)) * 4 + h)) * 128 + ((pos >> 4) & 127)];
            o0[k] = *(const u32x4*)(og + (size_t)t * BW + ch); o1[k] = *(const u32x4*)(og + ((size_t)NTOK + t) * BW + ch); o2[k] = *(const u32x4*)(og + ((size_t)2 * NTOK + t) * BW + ch);
            g[k] = *(const u32x4*)(proj + (size_t)t * DIN + C_CG + ch); }
        asm volatile("" ::: "memory");
#pragma unroll
        for (int k = 0; k < 8; ++k) { const int i = i0 + k * ngt; if (i >= NTOK * 64) continue; const int t = i >> 6, ch = (i & 63) * 8;
            const float mx = fmaxf(l0[k], fmaxf(l1[k], l2[k])); float a0 = fast_exp2(l0[k] - mx), a1 = fast_exp2(l1[k] - mx), a2 = fast_exp2(l2[k] - mx); const float inv = fast_rcp(a0 + a1 + a2); a0 *= inv; a1 *= inv; a2 *= inv;
            u32x4 w;
#define CMB(f) w.f = cvt_pk_bf16((a0 * bflo(o0[k].f) + a1 * bflo(o1[k].f) + a2 * bflo(o2[k].f)) * bflo(g[k].f), (a0 * bfhi(o0[k].f) + a1 * bfhi(o1[k].f) + a2 * bfhi(o2[k].f)) * bfhi(g[k].f))
            CMB(x); CMB(y); CMB(z); CMB(w);
#undef CMB
            *(u32x4*)(proj + (size_t)t * DIN + C_CG + ch) = w; }
    }
}

#define RLX_AGENT __ATOMIC_RELAXED, __HIP_MEMORY_SCOPE_AGENT
#define XB_TMO      128
#define XB_XCNT(j)  (256  + 64 * (j))
#define XB_XSUB(j)  (1280 + 64 * (j))
#define XB_XGEN(j)  (2304 + 64 * (j))
#define XB_TOP      3328
#define XB_TOPGEN   3392
#define XCD_BAR_WORDS 3456
#define XB_SPIN_CAP (1u << 18)

__device__ __forceinline__ unsigned xb_ld(unsigned* p)              { return __hip_atomic_load(p, __ATOMIC_RELAXED, __HIP_MEMORY_SCOPE_AGENT); }
__device__ __forceinline__ unsigned xb_add(unsigned* p, unsigned v) { return __hip_atomic_fetch_add(p, v, __ATOMIC_RELAXED, __HIP_MEMORY_SCOPE_AGENT); }
__device__ __forceinline__ unsigned xb_xcc_id() { return (unsigned)__builtin_amdgcn_s_getreg((3 << 11) | 20) & 0xFu; }
#define XB_SPIN(cond, bar) do { unsigned _sp = 0; while (cond) { __builtin_amdgcn_s_sleep(1); \
    if ((++_sp & 255u) == 0u) { if (xb_ld(&(bar)[XB_TMO])) break; if (_sp > XB_SPIN_CAP) { atomicAdd(&(bar)[XB_TMO], 1u); break; } } } } while (0)

struct XcdBarrier {
    unsigned* bar; unsigned x;
    volatile LAS unsigned* st;
};

__device__ __forceinline__ XcdBarrier xcd_barrier_post(unsigned* bar, volatile LAS unsigned* st) {
    XcdBarrier b; b.bar = bar; b.x = xb_xcc_id(); b.st = st;
    if (threadIdx.x == 0) (void)xb_add(&bar[XB_XCNT(b.x)], 1u);
    return b;
}
__device__ __forceinline__ void xcd_barrier_complete(unsigned* bar, unsigned x, unsigned& nloc, unsigned& nx) {
    const unsigned G = gridDim.x * gridDim.y * gridDim.z;
    unsigned sum, cnt, mine, sp = 0u;
    for (;;) {
        sum = 0u; cnt = 0u; mine = 0u;
#pragma unroll
        for (unsigned j = 0; j < 16; ++j) { const unsigned c = xb_ld(&bar[XB_XCNT(j)]); sum += c; cnt += (c > 0u) ? 1u : 0u; mine = (j == x) ? c : mine; }
        if (sum == G) break;
        __builtin_amdgcn_s_sleep(1);
        if ((++sp & 255u) == 0u) { if (xb_ld(&bar[XB_TMO])) break; if (sp > XB_SPIN_CAP) { atomicAdd(&bar[XB_TMO], 1u); break; } }
    }
    nloc = mine > 0u ? mine : 1u; nx = cnt > 0u ? cnt : 1u;
}

__device__ __forceinline__ void xcd_barrier(const XcdBarrier& b) {
    asm volatile("s_waitcnt vmcnt(0)" ::: "memory");
    __syncthreads();
    if (threadIdx.x == 0) {
        unsigned* bar = b.bar;
        __builtin_amdgcn_s_waitcnt(0);
        unsigned nloc = b.st[0], nx = b.st[1];
        if (nloc == 0u) { xcd_barrier_complete(bar, b.x, nloc, nx); b.st[0] = nloc; b.st[1] = nx; }
        const unsigned old = xb_add(&bar[XB_XSUB(b.x)], 1u);
        const unsigned gen = old / nloc;
        if (old + 1u == (gen + 1u) * nloc) {
            __builtin_amdgcn_fence(__ATOMIC_RELEASE, "agent");
            asm volatile("s_waitcnt vmcnt(0)" ::: "memory");
            const unsigned og = xb_add(&bar[XB_TOP], 1u);
            const unsigned tg = og / nx;
            if (og + 1u == (tg + 1u) * nx) xb_add(&bar[XB_TOPGEN], 1u);
            else XB_SPIN(xb_ld(&bar[XB_TOPGEN]) == tg, bar);
            __builtin_amdgcn_fence(__ATOMIC_ACQUIRE, "agent");
            xb_add(&bar[XB_XGEN(b.x)], 1u);
            asm volatile("s_waitcnt vmcnt(0)" ::: "memory");
        } else {
            XB_SPIN(xb_ld(&bar[XB_XGEN(b.x)]) == gen, bar);
            __builtin_amdgcn_fence(__ATOMIC_ACQUIRE, "agent");
            asm volatile("s_waitcnt vmcnt(0)" ::: "memory");
        }
    }
    __syncthreads();
}

#ifndef IT_MASK
#define IT_MASK 15
#endif
#ifndef PH_MASK
#define PH_MASK 31
#endif
__global__ void __launch_bounds__(NTHREADS, 2) mega_fwd(Params p) {
    extern __shared__ __attribute__((aligned(16))) unsigned char lds_raw[];
    LAS unsigned char* lds = (LAS unsigned char*)lds_raw;
    cg::grid_group grid = cg::this_grid();
    const int tid = threadIdx.x, lane = tid & 63, wave = __builtin_amdgcn_readfirstlane(tid >> 6);
    const int G = gridDim.x, bx = blockIdx.x;
    const int vcu = (G % 8 == 0) ? (bx % 8) * (G / 8) + bx / 8 : bx;
    unsigned char* ws = p.ws;
    bf16_t* proj = (bf16_t*)(ws + WS_PROJ);
    volatile LAS unsigned* xst = (volatile LAS unsigned*)(lds + LDS_BYTES - 64);
    if (tid < 16) xst[tid] = 0u;
    __syncthreads();
    (void)xcd_barrier_post((unsigned*)(ws + WS_CTL), xst);
    grid.sync();

    prologue(p, lds, vcu, G, wave, lane);
    { XcdBarrier xb_; xb_.bar = (unsigned*)(p.ws + WS_CTL); xb_.x = xb_xcc_id(); xb_.st = (volatile LAS unsigned*)(lds + LDS_BYTES - 64); xcd_barrier(xb_); }

    for (int l = 0; l < DEPTH; ++l) {
#if PH_MASK & 1
        { int tidp = threadIdx.x; asm volatile("" : "+v"(tidp));
        if (l == 0) {
            pg8::Gemm g{(const bf16_t*)(ws + WS_MEMB), (const bf16_t*)(ws + WS_WKV), DM, DM, DM};
            pg8::StaticOrder S; S.init(NB * MEMLEN, DEPTH * DM, G, (bx + G / 2) % G);
            pg8::EpiProj E{(bf16_t*)(ws + WS_MEMKV), DEPTH * DM, (const float*)(ws + WS_MEMSS), 1, 1.0f};
            pg8::gemm_phase<pg8::EpiProj, pg8::StaticOrder, true, true>(lds, g, S, E, tidp);
        }
        {
            pg8::Gemm g{(const bf16_t*)(ws + WS_XB8), (const bf16_t*)(ws + WS_WG8 + (size_t)l * DIN * DM), DM / 2, DM / 2, DM / 2};
            const int ntile = (NTOK / 256) * NT_FP8, full = ntile / G, rag = ntile - full * G;
            const bool halves = (l > 0) && (G % 2 == 0) && rag > 0 && rag <= G / 2;
            pg8::GateOrder S; S.base.init(NTOK, NT_FP8 * 256, G, bx); S.rounds = halves ? full : full + 1;
            pg8::EpiProj E{proj, DIN, (const float*)(ws + WS_ROWSS) + (size_t)l * NTOK, 0, 1.0f / WG8_SCALE};
            pg8::gemm_phase<pg8::EpiProj, pg8::GateOrder, true, true, false, true>(lds, g, S, E, tidp);
            if (halves) {
                pg8::ProjHalfOrder H; H.base.init(NTOK, NT_FP8 * 256, G, bx % (G / 2)); H.round = full; H.half = bx / (G / 2); H.hbytes = (long)128 * (DM / 2) * 2;
                pg8::EpiProjT<true> EH{proj, DIN, (const float*)(ws + WS_ROWSS) + (size_t)l * NTOK, 0, 1.0f / WG8_SCALE};
                pg8::gemm_phase<pg8::EpiProjT<true>, pg8::ProjHalfOrder, true, true, true, true>(lds, g, H, EH, tidp);
            }
        }
        {
            pg8::Gemm g{(const bf16_t*)(ws + WS_XB), (const bf16_t*)(ws + WS_WIN) + (size_t)l * DIN * DM, DM, DM, DM};
            pg8::ProjOrder S; S.base.init(NTOK, NT_BF16 * 256, G, bx); S.rounds = 1 << 20;
            pg8::EpiProj E{proj, DIN, (const float*)(ws + WS_ROWSS) + (size_t)l * NTOK, 0, 1.0f};
            pg8::gemm_phase<pg8::EpiProj, pg8::ProjOrder, true, true>(lds, g, S, E, tidp);
        }
        }
#endif
        { XcdBarrier xb_; xb_.bar = (unsigned*)(p.ws + WS_CTL); xb_.x = xb_xcc_id(); xb_.st = (volatile LAS unsigned*)(lds + LDS_BYTES - 64); xcd_barrier(xb_); }
#if PH_MASK & 2
        if (G == 256) {
            const int x = bx & 7, m = (bx >> 3) & 31;
            for (int k = 0; k < 2; ++k) { int tidp = threadIdx.x; asm volatile("" : "+v"(tidp)); const int lanep = tidp & 63, wavep = __builtin_amdgcn_readfirstlane(tidp >> 6);
                gmlp_item(p, l, (((k * 8 + x) * 8 + (m >> 2)) << 2) | (m & 3), lds, tidp, wavep, lanep); }
            for (int k = 0; k < 2; ++k) { int tidp = threadIdx.x; asm volatile("" : "+v"(tidp)); const int lanep = tidp & 63, wavep = __builtin_amdgcn_readfirstlane(tidp >> 6);
                const int j = bx + 256 * k; pool_item(p, l, k ? ((j & ~3) | (3 - (j & 3))) : j, lds, tidp, wavep, lanep); }
            for (int r = 0; r < 8; ++r) { int tidp = threadIdx.x; asm volatile("" : "+v"(tidp)); const int lanep = tidp & 63, wavep = __builtin_amdgcn_readfirstlane(tidp >> 6);
                const int idx = ((32 * ((x >> 2) + 2 * (r & 1)) + m) << 2) | (x & 3);
                if (r < 2) attn_item<0>(p, l, idx, lds, tidp, wavep, lanep); else if (r < 4) attn_item<1>(p, l, idx, lds, tidp, wavep, lanep);
                else if (r < 6) attn_item<2>(p, l, idx, lds, tidp, wavep, lanep); else attn_item<3>(p, l, idx, lds, tidp, wavep, lanep); }
        } else
        for (int it = bx; it < 3072; it += G) {
            int tidp = threadIdx.x; asm volatile("" : "+v"(tidp)); const int lanep = tidp & 63, wavep = __builtin_amdgcn_readfirstlane(tidp >> 6);
            const int cls = it >> 9, idx = it & 511;
            if (cls == 0) gmlp_item(p, l, idx, lds, tidp, wavep, lanep);
            else if (cls == 1) pool_item(p, l, idx, lds, tidp, wavep, lanep);
            else if (cls == 2) attn_item<0>(p, l, idx, lds, tidp, wavep, lanep);
            else if (cls == 3) attn_item<1>(p, l, idx, lds, tidp, wavep, lanep);
            else if (cls == 4) attn_item<2>(p, l, idx, lds, tidp, wavep, lanep);
            else attn_item<3>(p, l, idx, lds, tidp, wavep, lanep);
        }
#endif
        { XcdBarrier xb_; xb_.bar = (unsigned*)(p.ws + WS_CTL); xb_.x = xb_xcc_id(); xb_.st = (volatile LAS unsigned*)(lds + LDS_BYTES - 64); xcd_barrier(xb_); }
#if PH_MASK & 4
        { int tidp = threadIdx.x; asm volatile("" : "+v"(tidp)); combine_phase(p, bx * NTHREADS + tidp, G * NTHREADS); }
#endif
        { XcdBarrier xb_; xb_.bar = (unsigned*)(p.ws + WS_CTL); xb_.x = xb_xcc_id(); xb_.st = (volatile LAS unsigned*)(lds + LDS_BYTES - 64); xcd_barrier(xb_); }
#if PH_MASK & 8
        { int tidp = threadIdx.x; asm volatile("" : "+v"(tidp));
            pg8::Gemm g{proj, (const bf16_t*)(ws + WS_WBR) + (size_t)l * 4 * DM * BW, DIN, BW, BW};
            pg8::MergeOrder S; S.base.init(NTOK, DM, G, bx); S.bstep = (long)DM * BW * 2; S.a0 = C_AU * 2; S.a1 = C_PG * 2; S.a2 = C_CG * 2; S.a3 = C_MG * 2; S.astep = 0;
            pg8::EpiMerge E{proj + C_GM, DIN, (bf16_t*)(ws + WS_Z)};
            pg8::gemm_phase<pg8::EpiMerge, pg8::MergeOrder, true, true>(lds, g, S, E, tidp);
        }
#endif
        { XcdBarrier xb_; xb_.bar = (unsigned*)(p.ws + WS_CTL); xb_.x = xb_xcc_id(); xb_.st = (volatile LAS unsigned*)(lds + LDS_BYTES - 64); xcd_barrier(xb_); }
#if PH_MASK & 16
        { int tidp = threadIdx.x; asm volatile("" : "+v"(tidp));
            pg8::Gemm g{(const bf16_t*)(ws + WS_Z), (const bf16_t*)(ws + WS_WOUT) + (size_t)l * DM * DM, DM, DM, DM};
            pg8::StaticOrder S; S.init(NTOK, DM, G, bx);
            pg8::EpiOut E{l == 0 ? p.x : p.out, p.out, (bf16_t*)(ws + WS_XB), (float*)(ws + WS_ROWSS) + (size_t)(l + 1) * NTOK, ws + WS_XB8, l < DEPTH - 1};
            pg8::gemm_phase<pg8::EpiOut, pg8::StaticOrder, true, true>(lds, g, S, E, tidp);
        }
#endif
        { XcdBarrier xb_; xb_.bar = (unsigned*)(p.ws + WS_CTL); xb_.x = xb_xcc_id(); xb_.st = (volatile LAS unsigned*)(lds + LDS_BYTES - 64); xcd_barrier(xb_); }
    }
    {
        int tidf = threadIdx.x; asm volatile("" : "+v"(tidf)); const int lane = tidf & 63, wave = __builtin_amdgcn_readfirstlane(tidf >> 6);
        const int gw = vcu * NWAVES + wave, NGW = G * NWAVES; const float* ss = (const float*)(ws + WS_ROWSS) + (size_t)DEPTH * NTOK;
        f32x4 gg[4];
#pragma unroll
        for (int j = 0; j < 4; ++j) gg[j] = ((const f32x4*)p.final_norm_g)[lane + 64 * j];
        for (int m0 = gw; m0 < NTOK; m0 += 4 * NGW) {
            f32x4 v[4][4]; float sq[4];
#pragma unroll
            for (int i = 0; i < 4; ++i) { int m = m0 + i * NGW; if (m >= NTOK) m = m0; sq[i] = ss[m]; const f32x4* xr = (const f32x4*)(p.out + (size_t)m * DM) + lane;
#pragma unroll
                for (int j = 0; j < 4; ++j) v[i][j] = xr[64 * j]; }
            asm volatile("" ::: "memory");
#pragma unroll
            for (int i = 0; i < 4; ++i) { const int m = m0 + i * NGW; if (m >= NTOK) continue; const float rs = 1.0f / sqrtf(sq[i] * (1.0f / 1024.0f) + EPS); f32x4* xr = (f32x4*)(p.out + (size_t)m * DM) + lane;
#pragma unroll
                for (int j = 0; j < 4; ++j) xr[64 * j] = v[i][j] * rs * gg[j]; }
            asm volatile("" ::: "memory");
        }
    }
}

extern "C" void kernel_launch(void* const* d_in, const int* in_sizes, int n_in, void* d_out, int out_size, void* d_ws, size_t ws_size, hipStream_t stream) {
    static int grid = 0;
    if (grid == 0) {
        if (n_in != 15 || in_sizes[0] != NTOK * DM || out_size != NTOK * DM || ws_size < WS_END) { fprintf(stderr, "kernel_launch: unexpected shapes (n_in %d, in0 %d, out %d, ws %zu, need %zu)\n", n_in, n_in > 0 ? in_sizes[0] : -1, out_size, ws_size, (size_t)WS_END); grid = -1; return; }
        int dev = 0, cus = 0, per_cu = 0;
        hipGetDevice(&dev); hipDeviceGetAttribute(&cus, hipDeviceAttributeMultiprocessorCount, dev);
        if (hipFuncSetAttribute((const void*)mega_fwd, hipFuncAttributeMaxDynamicSharedMemorySize, LDS_BYTES) != hipSuccess) { fprintf(stderr, "kernel_launch: hipFuncSetAttribute failed\n"); grid = -1; return; }
        if (hipOccupancyMaxActiveBlocksPerMultiprocessor(&per_cu, (const void*)mega_fwd, NTHREADS, LDS_BYTES) != hipSuccess || per_cu < 1) { fprintf(stderr, "kernel_launch: occupancy query says %d blocks/CU\n", per_cu); grid = -1; return; }
        (void)hipGetLastError();
        grid = cus;
    }
    if (grid < 0) return;
    if (hipMemsetAsync((char*)d_ws + WS_CTL, 0, 16384, stream) != hipSuccess) { fprintf(stderr, "kernel_launch: memset failed\n"); return; }
    Params p{};
    p.x = (const float*)d_in[0]; p.mem = (const float*)d_in[1]; p.norm_g = (const float*)d_in[2]; p.w_in = (const float*)d_in[3]; p.gm_ln_g = (const float*)d_in[4]; p.gm_ln_b = (const float*)d_in[5];
    p.gm_ws = (const float*)d_in[6]; p.gm_bs = (const float*)d_in[7]; p.pool_w = (const float*)d_in[8]; p.pool_scale = (const float*)d_in[9]; p.mem_norm_g = (const float*)d_in[10];
    p.w_mem_kv = (const float*)d_in[11]; p.w_branch = (const float*)d_in[12]; p.w_out = (const float*)d_in[13]; p.final_norm_g = (const float*)d_in[14];
    p.out = (float*)d_out; p.ws = (unsigned char*)d_ws;
    void* args[] = {&p};
    hipError_t e = hipLaunchCooperativeKernel((const void*)mega_fwd, dim3(grid), dim3(NTHREADS), args, LDS_BYTES, stream);
    if (e != hipSuccess) fprintf(stderr, "kernel_launch: cooperative launch failed: %s (grid %d)\n", hipGetErrorString(e), grid);
}
```

```cpp
#include <hip/hip_runtime.h>
#include <hip/hip_cooperative_groups.h>
#include <cstdio>
#include <cstdint>
namespace cg = cooperative_groups;

#define LAS __attribute__((address_space(3)))
typedef unsigned short bf16_t;
typedef short bf16x8 __attribute__((ext_vector_type(8)));
typedef short s16x4 __attribute__((ext_vector_type(4)));
typedef float f32x4 __attribute__((ext_vector_type(4)));
typedef float f32x2 __attribute__((ext_vector_type(2)));
typedef unsigned u32x4 __attribute__((ext_vector_type(4)));
typedef unsigned u32x2 __attribute__((ext_vector_type(2)));

constexpr int NTOK = 16384, DM = 1024, DIN = 10752, BW = 512, SEQ = 4096, NB = 4, DEPTH = 4, MEMLEN = 256;
constexpr int C_AU = 0, C_AV = 512, C_AG = 1024, C_PI = 1536, C_PG = 2048, C_CQ = 2560, C_CK = 4096, C_CV = 4608, C_CG = 5120, C_MQ = 5632, C_MG = 6144, C_GM = 6656;
constexpr float EPS = 1e-6f;
constexpr int NGATE = 4096, NMIX = DIN - NGATE;
__host__ __device__ constexpr bool is_fp8_tile(int pn) { return (pn >= 10 && pn < 18) || (pn >= 20 && pn < 30) || pn >= 34; }
constexpr int NT_FP8 = 26, NT_BF16 = 16;
constexpr float WG8_SCALE = 64.0f;
constexpr float QSCALE = 0.08838834764831845f * 1.4426950408889634f;

constexpr size_t MiB = 1u << 20;
constexpr size_t WS_WIN = 0, WS_WBR = 84 * MiB, WS_WOUT = 100 * MiB, WS_WKV = 108 * MiB, WS_POOLW = 116 * MiB, WS_GMWS = 116 * MiB + 512 * 1024;
constexpr size_t WS_XB = 117 * MiB, WS_MEMB = 149 * MiB, WS_MEMKV = 151 * MiB, WS_ROWSS = 159 * MiB, WS_MEMSS = 159 * MiB + 512 * 1024, WS_LSE = 160 * MiB;
constexpr size_t WS_OG = 161 * MiB, WS_ZF = 209 * MiB, WS_XB8 = 209 * MiB  , WS_WG8 = 225 * MiB  , WS_PROJ = 273 * MiB, WS_Z = 609 * MiB, WS_CTL = 641 * MiB, WS_END = 642 * MiB;
constexpr int LDS_BYTES = 147456;

__device__ __forceinline__ float bflo(unsigned w) { return __uint_as_float(w << 16); }
__device__ __forceinline__ float bfhi(unsigned w) { return __uint_as_float(w & 0xffff0000u); }
__device__ __forceinline__ unsigned cvt_pk_bf16(float lo, float hi) { unsigned r; asm("v_cvt_pk_bf16_f32 %0, %1, %2" : "=v"(r) : "v"(lo), "v"(hi)); return r; }
__device__ __forceinline__ float fast_rcp(float x) { return __builtin_amdgcn_rcpf(x); }
__device__ __forceinline__ float fast_exp2(float x) { return __builtin_amdgcn_exp2f(x); }
__device__ __forceinline__ float sigmoidf_(float x) { return fast_rcp(1.0f + fast_exp2(-1.4426950408889634f * x)); }
__device__ __forceinline__ float siluf_(float x) { return x * sigmoidf_(x); }
__device__ __forceinline__ float geluf_(float v) {
    const float av = __builtin_fabsf(v), d = av * 0.2316418882f + 1.0f, t = fast_rcp(d);
    float q = t * 0.5307027145f + (-0.7265760135f); q = q * t + 0.7107068705f; q = q * t + (-0.142248368f); q = q * t + 0.127414796f; q = q * t;
    const float e = fast_exp2((v * v) * (-0.72134752044f));
    const float m = v * (q * e), r = v - m;
    return v < 0.f ? m : r;
}
namespace pg8 {
#define PG8_LAS __attribute__((address_space(3)))
constexpr int BM = 256, BK = 64, HALF = 128, HALF_ROWS = 128, HTB = HALF * BK * 2  , STAGE_BYTES = 8 * HTB, NXCD = 8, WGM = 8;

__host__ __device__ __forceinline__ int lds_byte(int r, int c) { const int st = (r >> 4) * 2 + (c >> 5), rr = r & 15, cc = c & 31, ob = rr * 64 + cc * 2; return st * 1024 + (ob ^ (((ob >> 9) & 1) << 5)); }
__host__ __device__ __forceinline__ void stage_rc(int b, int& R, int& C) { const int st = b / 1024, sb = b % 1024, swz = sb ^ (((sb >> 9) & 1) << 5); R = (st >> 1) * 16 + swz / 64; C = (st & 1) * 32 + (swz % 64) / 2; }
__host__ __device__ __forceinline__ int perm32(int rho) { const int n = rho >> 4, i = rho & 15; return 8 * (i >> 2) + 4 * n + (i & 3); }

typedef int i32x4 __attribute__((ext_vector_type(4))); typedef int i32x8 __attribute__((ext_vector_type(8)));
__device__ __forceinline__ i32x8 cat8i(bf16x8 a, bf16x8 b) { return __builtin_shufflevector(__builtin_bit_cast(i32x4, a), __builtin_bit_cast(i32x4, b), 0, 1, 2, 3, 4, 5, 6, 7); }
struct Unit { int pm, pn, z; long aoff, boff; };
struct Gemm { const bf16_t* A; const bf16_t* Bt; int lda, ldb, K; };

struct StaticOrder {
    int nM, nN, nwg, G, c;
    __host__ __device__ void init(int M, int N, int G_, int c_) { nM = M / BM; nN = N / BM; nwg = nM * nN; G = G_; c = c_; }
    __host__ __device__ bool next(int i, Unit& u) const {
        const long L = (long)i * G + c; if (L >= nwg) return false;
        int wgid = (int)L; { const int q = nwg / NXCD, r = nwg % NXCD, xcd = wgid % NXCD, off = wgid / NXCD; wgid = (xcd < r ? xcd * (q + 1) : r * (q + 1) + (xcd - r) * q) + off; }
        const int nig = WGM * nN, gid = wgid / nig, fm = gid * WGM, gsz = (nM - fm) < WGM ? (nM - fm) : WGM;
        u.pm = fm + ((wgid % nig) % gsz); u.pn = (wgid % nig) / gsz; u.z = 0; u.aoff = 0; u.boff = 0; return true;
    }
};
__host__ __device__ __forceinline__ int fp8_tile(int j) { return j < 8 ? 10 + j : (j < 18 ? 12 + j : 16 + j); }
__host__ __device__ __forceinline__ int bf16_tile(int j) { return j < 10 ? j : (j < 12 ? 8 + j : 18 + j); }
struct ProjOrder {
    StaticOrder base; int rounds;
    __device__ bool next(int i, Unit& u) const { if (i >= rounds || !base.next(i, u)) return false; u.pn = bf16_tile(u.pn); return true; }
};
struct ProjHalfOrder {
    StaticOrder base; int round, half; long hbytes;
    __device__ bool next(int i, Unit& u) const { if (i > 0 || !base.next(round, u)) return false; u.pn = fp8_tile(u.pn); u.z = half; u.aoff = half * hbytes; return true; }
};
struct GateOrder {
    StaticOrder base; int rounds;
    __device__ bool next(int i, Unit& u) const { if (i >= rounds || !base.next(i, u)) return false; u.pn = fp8_tile(u.pn); return true; }
};
struct MergeOrder {
    StaticOrder base; long astep, bstep; long a0, a1, a2, a3;
    __device__ bool next(int i, Unit& u) const {
        if (!base.next(i >> 2, u)) return false;
        const int z = i & 3; u.z = z; u.aoff = (z == 0 ? a0 : z == 1 ? a1 : z == 2 ? a2 : a3); u.boff = bstep * z; return true;
    }
};

template <class Epi, class Sched, bool ALIGN_EPI = false, bool SP2 = false, bool HALF_M = false, bool FP8 = false>
__device__ __forceinline__ void gemm_phase(PG8_LAS unsigned char* lds, const Gemm g, const Sched& S, const Epi& E, int tid) {
    const int wid = __builtin_amdgcn_readfirstlane(tid >> 6), lane = tid & 63, wr = wid >> 2, wc = wid & 3, fr = lane & 15, fq = lane >> 4;
    const int K = g.K, nt = K / BK;
    unsigned voffA[2], voffB[2];
#pragma unroll
    for (int i = 0; i < 2; ++i) { int R, C; stage_rc(tid * 16 + i * 8192, R, C); const int Rb = Epi::PERM ? ((R & ~31) + perm32(R & 31)) : R;
        voffA[i] = (unsigned)(R * g.lda + C) * 2u; voffB[i] = (unsigned)(Rb * g.ldb + C) * 2u; }
    const size_t kstep = (size_t)(BK * 2);
    const size_t hstepA = (size_t)HALF * g.lda * 2, hstepB = (size_t)HALF * g.ldb * 2;
    const unsigned ldsw = (unsigned)wid * 1024u;
    const int aoff = lds_byte(wr * 64 + fr, fq * 8), boff = lds_byte(wc * 32 + fr, fq * 8);
#define PG8_SA(b, h) (((b) * 2 + (h)) * HTB)
#define PG8_SB(b, h) ((4 + (b) * 2 + (h)) * HTB)
#define PG8_STAGE(bufoff, gbase, voff) do { _Pragma("unroll") for (int _i = 0; _i < 2; ++_i) \
        __builtin_amdgcn_global_load_lds((const unsigned*)((const char*)(gbase) + (voff)[_i]), (PG8_LAS unsigned*)(lds + (bufoff) + ldsw + _i * 8192), 16, 0, 0); } while (0)
#define PG8_LDA(dst, b, h) do { _Pragma("unroll") for (int m = 0; m < 4; ++m) { if constexpr (FP8) dst##8[m] = cat8i(*(const PG8_LAS bf16x8*)(lds + PG8_SA(b, h) + aoff + m * 2048), *(const PG8_LAS bf16x8*)(lds + PG8_SA(b, h) + aoff + m * 2048 + 1024)); \
        else { _Pragma("unroll") for (int k = 0; k < 2; ++k) dst[m][k] = *(const PG8_LAS bf16x8*)(lds + PG8_SA(b, h) + aoff + m * 2048 + k * 1024); } } } while (0)
#define PG8_LDB(dst, b, h) do { _Pragma("unroll") for (int n = 0; n < 2; ++n) { if constexpr (FP8) dst##8[n] = cat8i(*(const PG8_LAS bf16x8*)(lds + PG8_SB(b, h) + boff + n * 2048), *(const PG8_LAS bf16x8*)(lds + PG8_SB(b, h) + boff + n * 2048 + 1024)); \
        else { _Pragma("unroll") for (int k = 0; k < 2; ++k) dst[n][k] = *(const PG8_LAS bf16x8*)(lds + PG8_SB(b, h) + boff + n * 2048 + k * 1024); } } } while (0)
#define PG8_MMA(ai, bj, At, Bt) do { __builtin_amdgcn_s_setprio(1); _Pragma("unroll") for (int m = 0; m < 4; ++m) _Pragma("unroll") for (int n = 0; n < 2; ++n) { \
        if constexpr (FP8) asm volatile("v_mfma_scale_f32_16x16x128_f8f6f4 %0, %1, %2, %0, %3, %3 op_sel_hi:[0,0,0]" : "+v"(acc[ai][bj][m][n]) : "v"(Bt##8[n]), "v"(At##8[m]), "v"(sc8));   \
        else { _Pragma("unroll") for (int k = 0; k < 2; ++k) acc[ai][bj][m][n] = __builtin_amdgcn_mfma_f32_16x16x32_bf16(Bt[n][k], At[m][k], acc[ai][bj][m][n], 0, 0, 0); } } \
        __builtin_amdgcn_s_setprio(0); } while (0)
#define PG8_WAIT_V(n) asm volatile("s_waitcnt vmcnt(" #n ")" ::: "memory")
#define PG8_WAIT_L(n) asm volatile("s_waitcnt lgkmcnt(" #n ")" ::: "memory")
#define PG8_BAR __builtin_amdgcn_s_barrier()
#define PG8_SCHED __builtin_amdgcn_sched_barrier(0)
    Unit cur, nxt; int ui = 0;
    if (!S.next(0, cur)) return;
    f32x4 acc[2][2][4][2];
#pragma unroll
    for (int a = 0; a < 2; ++a)
#pragma unroll
        for (int b = 0; b < 2; ++b)
#pragma unroll
            for (int m = 0; m < 4; ++m)
#pragma unroll
                for (int n = 0; n < 2; ++n) acc[a][b][m][n] = (f32x4){0.f, 0.f, 0.f, 0.f};
    bf16x8 At[4][2], B0[2][2], B1[2][2];
    const int sc8 = 0x7f7f7f7f;
    i32x8 At8[4], B08[2], B18[2];
    const char* cA = (const char*)g.A + (size_t)cur.pm * 2 * hstepA + cur.aoff; const char* cB = (const char*)g.Bt + (size_t)cur.pn * 2 * hstepB + cur.boff;
    if constexpr (SP2) {
        PG8_STAGE(PG8_SB(0, 0), cB, voffB); PG8_STAGE(PG8_SB(0, 1), cB + hstepB, voffB); PG8_STAGE(PG8_SA(0, 0), cA, voffA); PG8_STAGE(PG8_SA(0, 1), cA + hstepA, voffA);
        if (wr == 1) PG8_BAR;
        PG8_WAIT_V(2); PG8_BAR;
        PG8_STAGE(PG8_SB(1, 0), cB + kstep, voffB); PG8_STAGE(PG8_SA(1, 0), cA + kstep, voffA); PG8_STAGE(PG8_SB(1, 1), cB + hstepB + kstep, voffB);
        PG8_WAIT_V(6); PG8_BAR;
    } else {
        PG8_STAGE(PG8_SB(0, 0), cB, voffB); PG8_STAGE(PG8_SA(0, 0), cA, voffA); PG8_STAGE(PG8_SB(0, 1), cB + hstepB, voffB); PG8_STAGE(PG8_SA(0, 1), cA + hstepA, voffA);
        if (wr == 1) PG8_BAR;
        PG8_WAIT_V(4); PG8_BAR;
        PG8_STAGE(PG8_SB(1, 0), cB + kstep, voffB); PG8_STAGE(PG8_SA(1, 0), cA + kstep, voffA); PG8_STAGE(PG8_SB(1, 1), cB + hstepB + kstep, voffB);
        PG8_WAIT_V(6); PG8_BAR;
    }
    for (;;) {
        const bool has_next = S.next(ui + 1, nxt);
        const char* nA = has_next ? (const char*)g.A + (size_t)nxt.pm * 2 * hstepA + nxt.aoff : cA; const char* nB = has_next ? (const char*)g.Bt + (size_t)nxt.pn * 2 * hstepB + nxt.boff : cB;
        for (int t = 0; t < nt; t += 2) {
            const bool last = (t == nt - 2);
            const char* a1 = cA + (size_t)(t + 1) * kstep;
            const char* a2 = last ? nA : cA + (size_t)(t + 2) * kstep; const char* b2 = last ? nB : cB + (size_t)(t + 2) * kstep;
            const char* a3 = a2 + kstep; const char* b3 = b2 + kstep;
            if constexpr (SP2) {
            PG8_LDB(B0, 0, 0); PG8_LDB(B1, 0, 1); PG8_SCHED; PG8_LDA(At, 0, 0); PG8_STAGE(PG8_SA(1, 1), a1 + hstepA, voffA);
            PG8_WAIT_V(8); PG8_WAIT_L(0); PG8_BAR; PG8_MMA(0, 0, At, B0); PG8_MMA(0, 1, At, B1); PG8_BAR; PG8_SCHED;
            if constexpr (!HALF_M) PG8_LDA(At, 0, 1); PG8_STAGE(PG8_SB(0, 0), b2, voffB); PG8_STAGE(PG8_SB(0, 1), b2 + hstepB, voffB); PG8_STAGE(PG8_SA(0, 0), a2, voffA);
            PG8_WAIT_V(8); PG8_WAIT_L(0); PG8_BAR; if constexpr (!HALF_M) { PG8_MMA(1, 0, At, B0); PG8_MMA(1, 1, At, B1); } PG8_BAR; PG8_SCHED;
            PG8_LDB(B0, 1, 0); PG8_LDB(B1, 1, 1); PG8_SCHED; PG8_LDA(At, 1, 0); PG8_STAGE(PG8_SA(0, 1), a2 + hstepA, voffA);
            PG8_WAIT_V(8); PG8_WAIT_L(0); PG8_BAR; PG8_MMA(0, 0, At, B0); PG8_MMA(0, 1, At, B1); PG8_BAR; PG8_SCHED;
            if constexpr (!HALF_M) PG8_LDA(At, 1, 1); PG8_STAGE(PG8_SB(1, 0), b3, voffB); PG8_STAGE(PG8_SB(1, 1), b3 + hstepB, voffB); PG8_STAGE(PG8_SA(1, 0), a3, voffA);
            PG8_WAIT_V(8); PG8_WAIT_L(0); PG8_BAR; if constexpr (!HALF_M) { PG8_MMA(1, 0, At, B0); PG8_MMA(1, 1, At, B1); } PG8_BAR; PG8_SCHED;
            } else {
            PG8_LDB(B0, 0, 0); PG8_SCHED; PG8_LDA(At, 0, 0); PG8_STAGE(PG8_SA(1, 1), a1 + hstepA, voffA);
            PG8_WAIT_L(8); PG8_BAR; PG8_WAIT_L(0); PG8_MMA(0, 0, At, B0); PG8_BAR; PG8_SCHED;
            PG8_LDB(B1, 0, 1); PG8_STAGE(PG8_SB(0, 0), b2, voffB);
            PG8_BAR; PG8_WAIT_L(0); PG8_MMA(0, 1, At, B1); PG8_BAR;
            PG8_LDA(At, 0, 1); PG8_STAGE(PG8_SA(0, 0), a2, voffA);
            PG8_BAR; PG8_WAIT_L(0); PG8_MMA(1, 0, At, B0); PG8_BAR; PG8_SCHED;
            PG8_STAGE(PG8_SB(0, 1), b2 + hstepB, voffB);
            PG8_WAIT_V(6); PG8_BAR; PG8_MMA(1, 1, At, B1); PG8_BAR;
            PG8_LDB(B0, 1, 0); PG8_SCHED; PG8_LDA(At, 1, 0); PG8_STAGE(PG8_SA(0, 1), a2 + hstepA, voffA);
            PG8_WAIT_L(8); PG8_BAR; PG8_WAIT_L(0); PG8_MMA(0, 0, At, B0); PG8_BAR; PG8_SCHED;
            PG8_LDB(B1, 1, 1); PG8_STAGE(PG8_SB(1, 0), b3, voffB);
            PG8_BAR; PG8_WAIT_L(0); PG8_MMA(0, 1, At, B1); PG8_BAR;
            PG8_LDA(At, 1, 1); PG8_STAGE(PG8_SA(1, 0), a3, voffA);
            PG8_BAR; PG8_WAIT_L(0); PG8_MMA(1, 0, At, B0); PG8_BAR; PG8_SCHED;
            PG8_STAGE(PG8_SB(1, 1), b3 + hstepB, voffB);
            PG8_WAIT_V(6); PG8_BAR; PG8_MMA(1, 1, At, B1); PG8_BAR;
            }
        }
        if constexpr (ALIGN_EPI) { if (wr == 0) PG8_BAR; }
        if constexpr (FP8) asm volatile("s_nop 15\n\ts_nop 15" ::: "memory");
        E(acc, cur, wr, wc, fr, fq);
        if (!has_next) break;
#pragma unroll
        for (int a = 0; a < 2; ++a)
#pragma unroll
            for (int b = 0; b < 2; ++b)
#pragma unroll
                for (int m = 0; m < 4; ++m)
#pragma unroll
                    for (int n = 0; n < 2; ++n) acc[a][b][m][n] = (f32x4){0.f, 0.f, 0.f, 0.f};
        cur = nxt; cA = nA; cB = nB; ++ui;
        if constexpr (ALIGN_EPI) { if (wr == 1) PG8_BAR; }
    }
    PG8_WAIT_V(0);
    if constexpr (!ALIGN_EPI) { if (wr == 0) PG8_BAR; }
    PG8_BAR;
#undef PG8_SA
#undef PG8_SB
#undef PG8_STAGE
#undef PG8_LDA
#undef PG8_LDB
#undef PG8_MMA
#undef PG8_WAIT_V
#undef PG8_WAIT_L
#undef PG8_BAR
#undef PG8_SCHED
}

template <bool HM = false> struct EpiProjT {
    static constexpr bool PERM = true;
    bf16_t* O; int ldc; const float* ss; int mode; float oscale;
    __device__ __forceinline__ int act_of(int pn) const {
        if (mode) return 0;
        if (pn < 4) return 1; if (pn < 6) return 2; if (pn < 8) return 0; if (pn < 10) return 2; if (pn < 16) return 4; if (pn < 20) return 0;
        if (pn < 22) return 2; if (pn < 24) return 4; if (pn < 26) return 2; return 3;
    }
    __device__ __forceinline__ void operator()(const f32x4 (&acc)[2][2][4][2], const Unit& u, int wr, int wc, int fr, int fq) const {
        const int row0 = u.pm * BM + (HM ? u.z * HALF_ROWS : 0) + wr * 64 + fr, col0 = u.pn * BM + wc * 32 + 8 * fq; const int act = act_of(u.pn);
        float ssv[2][4];
#pragma unroll
        for (int ai = 0; ai < (HM ? 1 : 2); ++ai)
#pragma unroll
            for (int m = 0; m < 4; ++m) ssv[ai][m] = ss[row0 + ai * HALF + m * 16];
        asm volatile("" ::: "memory");
#pragma unroll
        for (int ai = 0; ai < (HM ? 1 : 2); ++ai)
#pragma unroll
            for (int m = 0; m < 4; ++m) { const int row = row0 + ai * HALF + m * 16; const float rs = oscale / sqrtf(ssv[ai][m] * (1.0f / 1024.0f) + EPS);
                bf16_t* rowp = O + (size_t)row * ldc + col0;
#pragma unroll
                for (int bj = 0; bj < 2; ++bj) { f32x4 v0 = acc[ai][bj][m][0] * rs, v1 = acc[ai][bj][m][1] * rs;
                    if (act == 1) { for (int e = 0; e < 4; ++e) { v0[e] = geluf_(v0[e]); v1[e] = geluf_(v1[e]); } }
                    else if (act == 2) { for (int e = 0; e < 4; ++e) { v0[e] = siluf_(v0[e]); v1[e] = siluf_(v1[e]); } }
                    else if (act == 3) {
                        unsigned q[8];
                        for (int e = 0; e < 4; ++e) { q[e] = (unsigned)(sigmoidf_(v0[e]) * 255.0f + 0.5f); q[4 + e] = (unsigned)(sigmoidf_(v1[e]) * 255.0f + 0.5f); }
                        u32x2 w8; w8.x = q[0] | (q[1] << 8) | (q[2] << 16) | (q[3] << 24); w8.y = q[4] | (q[5] << 8) | (q[6] << 16) | (q[7] << 24);
                        *(u32x2*)((unsigned char*)(O + (size_t)row * ldc + C_GM) + (col0 + bj * HALF - C_GM)) = w8; continue; }
                    else if (act == 4) { v0 = v0 * QSCALE; v1 = v1 * QSCALE; }
                    u32x4 w; w.x = cvt_pk_bf16(v0[0], v0[1]); w.y = cvt_pk_bf16(v0[2], v0[3]); w.z = cvt_pk_bf16(v1[0], v1[1]); w.w = cvt_pk_bf16(v1[2], v1[3]);
                    *(u32x4*)(rowp + bj * HALF) = w; } }
    }
};
typedef EpiProjT<false> EpiProj;
struct EpiMerge {
    static constexpr bool PERM = true;
    const bf16_t* gates; int ldg; bf16_t* Z;
    __device__ __forceinline__ void operator()(const f32x4 (&acc)[2][2][4][2], const Unit& u, int wr, int wc, int fr, int fq) const {
        const int row0 = u.pm * BM + wr * 64 + fr, col0 = u.pn * BM + wc * 32 + 8 * fq; const int z = u.z;
        const unsigned char* gbase = (const unsigned char*)(gates + (size_t)row0 * ldg) + z * DM + col0; bf16_t* zbase = Z + (size_t)row0 * DM + col0;
        u32x2 gw[8][2]; u32x4 pz[8][2];
#define EM_LOAD(s) do { const int r_ = ((s) >> 2) * HALF + ((s) & 3) * 16; _Pragma("unroll") for (int bj = 0; bj < 2; ++bj) { gw[s][bj] = *(const u32x2*)(gbase + (size_t)r_ * ldg * 2 + bj * HALF); \
            if (z > 0) pz[s][bj] = *(const u32x4*)(zbase + (size_t)r_ * DM + bj * HALF); else pz[s][bj] = (u32x4){0u, 0u, 0u, 0u}; } } while (0)
        EM_LOAD(0); EM_LOAD(1); EM_LOAD(2); asm volatile("" ::: "memory");
#pragma unroll
        for (int s = 0; s < 8; ++s) {
            if (s + 3 < 8) { EM_LOAD(s + 3); }
            asm volatile("" ::: "memory");
            const int ai = s >> 2, m = s & 3, r_ = ai * HALF + m * 16;
#pragma unroll
            for (int bj = 0; bj < 2; ++bj) { const u32x2 g = gw[s][bj]; const u32x4 q = pz[s][bj]; const float k255 = 1.0f / 255.0f;
                f32x4 v0 = acc[ai][bj][m][0] * k255, v1 = acc[ai][bj][m][1] * k255;
                v0[0] = v0[0] * (float)((g.x >> 0) & 0xffu) + bflo(q.x); v0[1] = v0[1] * (float)((g.x >> 8) & 0xffu) + bfhi(q.x); v0[2] = v0[2] * (float)((g.x >> 16) & 0xffu) + bflo(q.y); v0[3] = v0[3] * (float)((g.x >> 24) & 0xffu) + bfhi(q.y);
                v1[0] = v1[0] * (float)((g.y >> 0) & 0xffu) + bflo(q.z); v1[1] = v1[1] * (float)((g.y >> 8) & 0xffu) + bfhi(q.z); v1[2] = v1[2] * (float)((g.y >> 16) & 0xffu) + bflo(q.w); v1[3] = v1[3] * (float)((g.y >> 24) & 0xffu) + bfhi(q.w);
                u32x4 w; w.x = cvt_pk_bf16(v0[0], v0[1]); w.y = cvt_pk_bf16(v0[2], v0[3]); w.z = cvt_pk_bf16(v1[0], v1[1]); w.w = cvt_pk_bf16(v1[2], v1[3]);
                *(u32x4*)(zbase + (size_t)r_ * DM + bj * HALF) = w; }
            asm volatile("" ::: "memory");
        }
#undef EM_LOAD
    }
};
struct EpiOut {
    static constexpr bool PERM = true;
    const float* xi; float* xo; bf16_t* xb; float* ssn; unsigned char* xb8; int wr_xb;
    __device__ __forceinline__ void operator()(const f32x4 (&acc)[2][2][4][2], const Unit& u, int wr, int wc, int fr, int fq) const {
        const int row0 = u.pm * BM + wr * 64 + fr, col0 = u.pn * BM + wc * 32 + 8 * fq;
        const size_t base = (size_t)row0 * DM + col0;
        f32x4 xv[8][2][2];
#define EO_LOAD(s) do { const size_t o_ = base + (size_t)(((s) >> 2) * HALF + ((s) & 3) * 16) * DM; _Pragma("unroll") for (int bj = 0; bj < 2; ++bj) { \
            xv[s][bj][0] = *(const f32x4*)(xi + o_ + bj * HALF); xv[s][bj][1] = *(const f32x4*)(xi + o_ + bj * HALF + 4); } } while (0)
        EO_LOAD(0); EO_LOAD(1); EO_LOAD(2); asm volatile("" ::: "memory");
#pragma unroll
        for (int s = 0; s < 8; ++s) {
            if (s + 3 < 8) { EO_LOAD(s + 3); }
            asm volatile("" ::: "memory");
            const int ai = s >> 2, m = s & 3; const size_t o_ = base + (size_t)(ai * HALF + m * 16) * DM; float sq = 0.f;
#pragma unroll
            for (int bj = 0; bj < 2; ++bj) { const f32x4 v0 = xv[s][bj][0] + acc[ai][bj][m][0], v1 = xv[s][bj][1] + acc[ai][bj][m][1];
                *(f32x4*)(xo + o_ + bj * HALF) = v0; *(f32x4*)(xo + o_ + bj * HALF + 4) = v1;
                u32x4 w; w.x = cvt_pk_bf16(v0[0], v0[1]); w.y = cvt_pk_bf16(v0[2], v0[3]); w.z = cvt_pk_bf16(v1[0], v1[1]); w.w = cvt_pk_bf16(v1[2], v1[3]);
                if (wr_xb) { *(u32x4*)(xb + o_ + bj * HALF) = w;
                  u32x2 w8; int t8 = 0; t8 = __builtin_amdgcn_cvt_pk_fp8_f32(v0[0], v0[1], t8, false); t8 = __builtin_amdgcn_cvt_pk_fp8_f32(v0[2], v0[3], t8, true); w8.x = (unsigned)t8;
                  t8 = 0; t8 = __builtin_amdgcn_cvt_pk_fp8_f32(v1[0], v1[1], t8, false); t8 = __builtin_amdgcn_cvt_pk_fp8_f32(v1[2], v1[3], t8, true); w8.y = (unsigned)t8; *(u32x2*)(xb8 + o_ + bj * HALF) = w8; }
                sq += (v0[0] * v0[0] + v0[1] * v0[1]) + (v0[2] * v0[2] + v0[3] * v0[3]) + (v1[0] * v1[0] + v1[1] * v1[1]) + (v1[2] * v1[2] + v1[3] * v1[3]); }
            sq += __shfl_xor(sq, 16); sq += __shfl_xor(sq, 32);
            if (fq == 0) atomicAdd(ssn + row0 + ai * HALF + m * 16, sq);
            asm volatile("" ::: "memory");
        }
#undef EO_LOAD
    }
};
}
struct Params {
    const float *x, *mem, *norm_g, *w_in, *gm_ln_g, *gm_ln_b, *gm_ws, *gm_bs, *pool_w, *pool_scale, *mem_norm_g, *w_mem_kv, *w_branch, *w_out, *final_norm_g;
    float* out; unsigned char* ws;
};
constexpr int NWAVES = 8, NTHREADS = 512;
#define LDS_WAIT() asm volatile("s_waitcnt lgkmcnt(0)" ::: "memory")

__device__ __forceinline__ float wave_sum(float v) {
#pragma unroll
    for (int o = 1; o < 64; o <<= 1) v += __shfl_xor(v, o);
    return v;
}
__device__ __forceinline__ s16x4 vtr(const LAS unsigned char* p) { return __builtin_bit_cast(s16x4, __builtin_amdgcn_ds_read_tr16_b64_v4i16((LAS s16x4*)p)); }
__device__ __forceinline__ bf16x8 cat8(s16x4 a, s16x4 b) { return __builtin_shufflevector(a, b, 0, 1, 2, 3, 4, 5, 6, 7); }

template <bool F8 = false> __device__ __forceinline__ void p0_transpose_item(const float* W, int K, int N, bf16_t* WT, const float* ks, LAS float* scr, int item, int lane, unsigned char* WT8 = nullptr, int n8 = 0, float s8 = 1.f) {
    const int nblk = N / 64, kb = item / nblk, nb = item % nblk, k0 = 64 * kb, n0 = 64 * nb;
    const int lr = lane >> 4, lc = (lane & 15) * 4;
    f32x4 v[16];
#pragma unroll
    for (int i = 0; i < 16; ++i) v[i] = *(const f32x4*)(W + (size_t)(k0 + 4 * i + lr) * N + n0 + lc);
#pragma unroll
    for (int i = 0; i < 16; ++i) { const int k = 4 * i + lr; const float sc = ks ? ks[k0 + k] : 1.0f;
        *(LAS f32x4*)(scr + k * 64 + (lc ^ (4 * ((k >> 3) & 7)))) = v[i] * sc; }
    LDS_WAIT(); asm volatile("" ::: "memory");
    const int c = lane & 7;
#pragma unroll
    for (int j = 0; j < 8; ++j) { const int n = (lane >> 3) + 8 * j; const LAS float* s = scr + (8 * c) * 64 + (n ^ (4 * c));
        u32x4 o; o.x = cvt_pk_bf16(s[0 * 64], s[1 * 64]); o.y = cvt_pk_bf16(s[2 * 64], s[3 * 64]); o.z = cvt_pk_bf16(s[4 * 64], s[5 * 64]); o.w = cvt_pk_bf16(s[6 * 64], s[7 * 64]);
        if (F8 && is_fp8_tile(n0 >> 8)) { u32x2 o8; int t8 = 0; t8 = __builtin_amdgcn_cvt_pk_fp8_f32(s[0 * 64] * s8, s[1 * 64] * s8, t8, false); t8 = __builtin_amdgcn_cvt_pk_fp8_f32(s[2 * 64] * s8, s[3 * 64] * s8, t8, true); o8.x = (unsigned)t8;
            t8 = 0; t8 = __builtin_amdgcn_cvt_pk_fp8_f32(s[4 * 64] * s8, s[5 * 64] * s8, t8, false); t8 = __builtin_amdgcn_cvt_pk_fp8_f32(s[6 * 64] * s8, s[7 * 64] * s8, t8, true); o8.y = (unsigned)t8;
            *(u32x2*)(WT8 + (size_t)(n0 + n) * K + k0 + 8 * c) = o8; }
        else *(u32x4*)(WT + (size_t)(n0 + n) * K + k0 + 8 * c) = o; }
    LDS_WAIT(); asm volatile("" ::: "memory");
}
__device__ __forceinline__ void row_to_bf16(const float* xrow, bf16_t* orow, float* ssp, int lane, unsigned char* o8row = nullptr) {
    const f32x4* xr = (const f32x4*)xrow + lane;
    f32x4 v[4]; float s = 0.f;
#pragma unroll
    for (int j = 0; j < 4; ++j) { v[j] = xr[64 * j]; s += (v[j].x * v[j].x + v[j].y * v[j].y) + (v[j].z * v[j].z + v[j].w * v[j].w); }
    s = wave_sum(s);
    u32x2* o8 = (u32x2*)orow + lane;
#pragma unroll
    for (int j = 0; j < 4; ++j) { u32x2 w; w.x = cvt_pk_bf16(v[j].x, v[j].y); w.y = cvt_pk_bf16(v[j].z, v[j].w); o8[64 * j] = w; }
    if (o8row) { unsigned* o4 = (unsigned*)o8row + lane;
#pragma unroll
        for (int j = 0; j < 4; ++j) { int t8 = 0; t8 = __builtin_amdgcn_cvt_pk_fp8_f32(v[j].x, v[j].y, t8, false); t8 = __builtin_amdgcn_cvt_pk_fp8_f32(v[j].z, v[j].w, t8, true); o4[64 * j] = (unsigned)t8; } }
    if (lane == 0) *ssp = s;
}

__device__ __forceinline__ void prologue(const Params& p, LAS unsigned char* lds, int vcu, int G, int wave, int lane) {
    unsigned char* ws = p.ws;
    LAS float* scr = (LAS float*)(lds + wave * 16384);
    const int gw = vcu * NWAVES + wave, NGW = G * NWAVES;
    constexpr int I_IN = (DM / 64) * (DIN / 64);
    constexpr int I_BR = (BW / 64) * (DM / 64);
    constexpr int I_SQ = (DM / 64) * (DM / 64);
    constexpr int I_PW = (128 / 64) * (128 / 64);
    constexpr int N_IN = DEPTH * I_IN, N_BR = DEPTH * 4 * I_BR, N_SQ = DEPTH * I_SQ, N_PW = DEPTH * 4 * I_PW;
    constexpr int NITEMS = N_IN + N_BR + 2 * N_SQ + N_PW;
    for (int it = gw; it < NITEMS; it += NGW) {
        int r = it;
        if (r < N_IN) { const int l = r / I_IN; p0_transpose_item<true>(p.w_in + (size_t)l * DM * DIN, DM, DIN, (bf16_t*)(ws + WS_WIN) + (size_t)l * DIN * DM, p.norm_g + l * DM, scr, r % I_IN, lane, ws + WS_WG8 + (size_t)l * DIN * DM, 0, WG8_SCALE); continue; } r -= N_IN;
        if (r < N_BR) { const int lb = r / I_BR; p0_transpose_item(p.w_branch + (size_t)lb * BW * DM, BW, DM, (bf16_t*)(ws + WS_WBR) + (size_t)lb * DM * BW, nullptr, scr, r % I_BR, lane); continue; } r -= N_BR;
        if (r < N_SQ) { const int l = r / I_SQ; p0_transpose_item(p.w_out + (size_t)l * DM * DM, DM, DM, (bf16_t*)(ws + WS_WOUT) + (size_t)l * DM * DM, nullptr, scr, r % I_SQ, lane); continue; } r -= N_SQ;
        if (r < N_SQ) { const int l = r / I_SQ; p0_transpose_item(p.w_mem_kv + (size_t)l * DM * DM, DM, DM, (bf16_t*)(ws + WS_WKV) + (size_t)l * DM * DM, p.mem_norm_g + l * DM, scr, r % I_SQ, lane); continue; } r -= N_SQ;
        { const int lg = r / I_PW; p0_transpose_item(p.pool_w + (size_t)lg * 128 * 128, 128, 128, (bf16_t*)(ws + WS_POOLW) + (size_t)lg * 128 * 128, nullptr, scr, r % I_PW, lane); }
    }
    { const int gt = gw * 64 + lane, NGT = NGW * 64; bf16_t* o = (bf16_t*)(ws + WS_GMWS);
      for (int i = gt; i < DEPTH * 4 * 128 * 128 / 2; i += NGT) { const int e = 2 * i, s = e & 127, t = (e >> 7) & 127; const f32x2 v = *(const f32x2*)(p.gm_ws + e);
          ((unsigned*)o)[i] = cvt_pk_bf16(s <= t ? v.x : 0.f, (s + 1) <= t ? v.y : 0.f); }
      float* ss = (float*)(ws + WS_ROWSS);
      for (int i = gt; i < 4 * NTOK; i += NGT) ss[NTOK + i] = 0.f; }
    for (int m = gw; m < NTOK; m += 2 * NGW) {
        const int m1 = (m + NGW < NTOK) ? m + NGW : m;
        const f32x4* xa = (const f32x4*)(p.x + (size_t)m * DM) + lane; const f32x4* xb_ = (const f32x4*)(p.x + (size_t)m1 * DM) + lane;
        f32x4 va[4], vb[4]; float sa = 0.f, sb = 0.f;
#pragma unroll
        for (int j = 0; j < 4; ++j) { va[j] = xa[64 * j]; vb[j] = xb_[64 * j]; }
#pragma unroll
        for (int j = 0; j < 4; ++j) { sa += (va[j].x * va[j].x + va[j].y * va[j].y) + (va[j].z * va[j].z + va[j].w * va[j].w); sb += (vb[j].x * vb[j].x + vb[j].y * vb[j].y) + (vb[j].z * vb[j].z + vb[j].w * vb[j].w); }
#pragma unroll
        for (int o = 1; o < 64; o <<= 1) { sa += __shfl_xor(sa, o); sb += __shfl_xor(sb, o); }
        u32x2* oa = (u32x2*)((bf16_t*)(ws + WS_XB) + (size_t)m * DM) + lane; u32x2* ob = (u32x2*)((bf16_t*)(ws + WS_XB) + (size_t)m1 * DM) + lane;
        unsigned* qa = (unsigned*)(ws + WS_XB8 + (size_t)m * DM) + lane; unsigned* qb = (unsigned*)(ws + WS_XB8 + (size_t)m1 * DM) + lane;
#pragma unroll
        for (int j = 0; j < 4; ++j) { u32x2 w; w.x = cvt_pk_bf16(va[j].x, va[j].y); w.y = cvt_pk_bf16(va[j].z, va[j].w); oa[64 * j] = w; w.x = cvt_pk_bf16(vb[j].x, vb[j].y); w.y = cvt_pk_bf16(vb[j].z, vb[j].w); ob[64 * j] = w;
            int t8 = 0; t8 = __builtin_amdgcn_cvt_pk_fp8_f32(va[j].x, va[j].y, t8, false); t8 = __builtin_amdgcn_cvt_pk_fp8_f32(va[j].z, va[j].w, t8, true); qa[64 * j] = (unsigned)t8;
            t8 = 0; t8 = __builtin_amdgcn_cvt_pk_fp8_f32(vb[j].x, vb[j].y, t8, false); t8 = __builtin_amdgcn_cvt_pk_fp8_f32(vb[j].z, vb[j].w, t8, true); qb[64 * j] = (unsigned)t8; }
        if (lane == 0) { ((float*)(ws + WS_ROWSS))[m] = sa; ((float*)(ws + WS_ROWSS))[m1] = sb; }
    }
    for (int m = gw; m < NB * MEMLEN; m += NGW) row_to_bf16(p.mem + (size_t)m * DM, (bf16_t*)(ws + WS_MEMB) + (size_t)m * DM, (float*)(ws + WS_MEMSS) + m, lane);
}

constexpr int KP = 272, VP = 288;
constexpr int ATT_V_OFF = 256 * KP;
struct AttnCtx { int h, n, dil, tq0, tk0; const bf16_t *Kb, *Vb, *Qb; size_t kvp; };
template <int kind> __device__ __forceinline__ AttnCtx attn_decode(const Params& p, int l, int idx) {
    bf16_t* proj = (bf16_t*)(p.ws + WS_PROJ);
    AttnCtx c; c.h = idx & 3; const int rest = idx >> 2; c.dil = 1; c.n = 0;
    if (kind < 3) {
        c.dil = (kind == 0) ? 1 : (kind == 1 ? 4 : 16); const int nb = 32 / c.dil;
        c.n = rest % nb; const int r = (rest / nb) % c.dil, b = rest / (nb * c.dil);
        c.tq0 = b * SEQ + (c.n * 128) * c.dil + r;
        c.tk0 = b * SEQ + ((c.n - 1) * 128) * c.dil + r;
        c.Kb = proj + C_CK + c.h * 128; c.Vb = proj + C_CV + c.h * 128; c.kvp = DIN; c.Qb = proj + C_CQ + kind * BW + c.h * 128;
    } else {
        const int b = rest >> 5; c.tq0 = rest * 128; c.tk0 = b * MEMLEN;
        const bf16_t* kv = (const bf16_t*)(p.ws + WS_MEMKV) + l * DM + c.h * 128; c.Kb = kv; c.Vb = kv + BW; c.kvp = DEPTH * DM; c.Qb = proj + C_MQ + c.h * 128;
    }
    return c;
}
template <int kind> __device__ __forceinline__ void attn_issue(const Params& p, int l, int idx, int tid, int wave, int lane, u32x4 (&kreg)[8], u32x4 (&vreg)[8], bf16x8 (&qf)[4]) {
    const AttnCtx c = attn_decode<kind>(p, l, idx);
    const int ch = tid & 15, r0 = tid >> 4, fr = lane & 15, fq = lane >> 4;
#pragma unroll
    for (int i = 0; i < 8; ++i) { const int j = r0 + 32 * i; int tok = c.tk0 + j * c.dil; if (kind < 3 && c.n == 0 && j < 128) tok = c.tq0;
        kreg[i] = *(const u32x4*)(c.Kb + (size_t)tok * c.kvp + ch * 8); vreg[i] = *(const u32x4*)(c.Vb + (size_t)tok * c.kvp + ch * 8); }
    const size_t qtok = (size_t)(c.tq0 + (16 * wave + fr) * c.dil);
#pragma unroll
    for (int ks = 0; ks < 4; ++ks) qf[ks] = *(const bf16x8*)(c.Qb + qtok * DIN + 32 * ks + 8 * fq);
    asm volatile("" ::: "memory");
}
__device__ __forceinline__ void attn_stage(LAS unsigned char* lds, int tid, const u32x4 (&kreg)[8], const u32x4 (&vreg)[8]) {
    const int ch = tid & 15, r0 = tid >> 4;
#pragma unroll
    for (int i = 0; i < 8; ++i) { const int j = r0 + 32 * i;
        *(LAS u32x4*)(lds + j * KP + ch * 16) = kreg[i]; *(LAS u32x4*)(lds + ATT_V_OFF + j * VP + ch * 16) = vreg[i]; }
    __syncthreads();
}
template <int kind> __device__ __forceinline__ void attn_compute(const Params& p, int l, int idx, LAS unsigned char* lds, int wave, int lane, const bf16x8 (&qf)[4]) {
    bf16_t* proj = (bf16_t*)(p.ws + WS_PROJ);
    const AttnCtx c = attn_decode<kind>(p, l, idx);
    const int h = c.h, n = c.n, dil = c.dil;
    const int fr = lane & 15, fq = lane >> 4;
    const int qi = 16 * wave + fr; const size_t qtok = (size_t)(c.tq0 + qi * dil);
    u32x2 mg[8];
    if (kind == 3) { const bf16_t* gp0 = proj + qtok * DIN + C_MG + h * 128 + 4 * fq;
#pragma unroll
        for (int dt = 0; dt < 8; ++dt) mg[dt] = *(const u32x2*)(gp0 + 16 * dt); }
    const int tlo = (kind < 3) ? wave : 0, thi = (kind < 3) ? wave + 8 : 15;
    f32x4 s[16];
#pragma unroll
    for (int t = 0; t < 16; ++t) { s[t] = (f32x4){0.f, 0.f, 0.f, 0.f};
        if (t >= tlo && t <= thi) {
#pragma unroll
        for (int ks = 0; ks < 4; ++ks) { const bf16x8 kf = *(const LAS bf16x8*)(lds + (16 * t + fr) * KP + (32 * ks + 8 * fq) * 2);
            s[t] = __builtin_amdgcn_mfma_f32_16x16x32_bf16(kf, qf[ks], s[t], 0, 0, 0); } } }
    if (kind < 3) {
        const int jlo = (n == 0) ? (qi > 128 ? qi : 128) : qi, jhi = qi + 128;
#pragma unroll
        for (int t = 0; t < 16; ++t)
#pragma unroll
            for (int e = 0; e < 4; ++e) { const int j = 16 * t + 4 * fq + e; if (j < jlo || j > jhi) s[t][e] = -1e30f; }
    }
    float mx = -3e38f;
#pragma unroll
    for (int t = 0; t < 16; ++t) mx = fmaxf(fmaxf(fmaxf(s[t][0], s[t][1]), fmaxf(s[t][2], s[t][3])), mx);
    mx = fmaxf(mx, __shfl_xor(mx, 16)); mx = fmaxf(mx, __shfl_xor(mx, 32));
    float sum = 0.f;
#pragma unroll
    for (int t = 0; t < 16; ++t)
#pragma unroll
        for (int e = 0; e < 4; ++e) { const float pe = fast_exp2(s[t][e] - mx); s[t][e] = pe; sum += pe; }
    sum += __shfl_xor(sum, 16); sum += __shfl_xor(sum, 32);
    f32x4 o[8];
#pragma unroll
    for (int dt = 0; dt < 8; ++dt) o[dt] = (f32x4){0.f, 0.f, 0.f, 0.f};
    const LAS unsigned char* vbase = lds + ATT_V_OFF + (4 * fq + (fr >> 2)) * VP + (fr & 3) * 8;
#pragma unroll
    for (int j = 0; j < 8; ++j) {
        u32x4 pw; pw.x = cvt_pk_bf16(s[2 * j][0], s[2 * j][1]); pw.y = cvt_pk_bf16(s[2 * j][2], s[2 * j][3]); pw.z = cvt_pk_bf16(s[2 * j + 1][0], s[2 * j + 1][1]); pw.w = cvt_pk_bf16(s[2 * j + 1][2], s[2 * j + 1][3]);
        const bf16x8 pf = __builtin_bit_cast(bf16x8, pw);
        if (2 * j + 1 >= tlo && 2 * j <= thi)
#pragma unroll
        for (int dt = 0; dt < 8; ++dt) { const s16x4 v0 = vtr(vbase + (32 * j) * VP + dt * 32), v1 = vtr(vbase + (32 * j + 16) * VP + dt * 32);
            o[dt] = __builtin_amdgcn_mfma_f32_16x16x32_bf16(cat8(v0, v1), pf, o[dt], 0, 0, 0); }
    }
    const float inv = fast_rcp(sum);
    if (kind < 3) {
        bf16_t* og = (bf16_t*)(p.ws + WS_OG) + ((size_t)kind * NTOK + qtok) * BW + h * 128 + 4 * fq;
#pragma unroll
        for (int dt = 0; dt < 8; ++dt) { u32x2 w; w.x = cvt_pk_bf16(o[dt][0] * inv, o[dt][1] * inv); w.y = cvt_pk_bf16(o[dt][2] * inv, o[dt][3] * inv); *(u32x2*)(og + 16 * dt) = w; }
        if (fq == 0) ((float*)(p.ws + WS_LSE))[((size_t)kind * 512 + idx) * 128 + qi] = mx + __builtin_amdgcn_logf(sum);
    } else {
        bf16_t* gp = proj + qtok * DIN + C_MG + h * 128 + 4 * fq;
#pragma unroll
        for (int dt = 0; dt < 8; ++dt) { const u32x2 g = mg[dt]; u32x2 w;
            w.x = cvt_pk_bf16(o[dt][0] * inv * bflo(g.x), o[dt][1] * inv * bfhi(g.x)); w.y = cvt_pk_bf16(o[dt][2] * inv * bflo(g.y), o[dt][3] * inv * bfhi(g.y)); *(u32x2*)(gp + 16 * dt) = w; }
    }
    __syncthreads();
}

template <int kind> __device__ __forceinline__ void attn_item(const Params& p, int l, int idx, LAS unsigned char* lds, int tid, int wave, int lane) {
    u32x4 kreg[8], vreg[8]; bf16x8 qf[4];
    attn_issue<kind>(p, l, idx, tid, wave, lane, kreg, vreg, qf);
    attn_stage(lds, tid, kreg, vreg);
    attn_compute<kind>(p, l, idx, lds, wave, lane, qf);
}

__device__ __forceinline__ void gmlp_item(const Params& p, int l, int idx, LAS unsigned char* lds, int tid, int wave, int lane) {
    bf16_t* proj = (bf16_t*)(p.ws + WS_PROJ);
    const int h = idx & 3, c = idx >> 2, t0 = c * 128;
    const int fr = lane & 15, fq = lane >> 4;
    {
        const int lg = lane >> 4, lc = lane & 15;
        const bf16_t* vbase = proj + (size_t)(t0 + 16 * wave + lg) * DIN + C_AV + lc * 8;
        u32x4 wv[4][4];
#pragma unroll
        for (int tg = 0; tg < 4; ++tg)
#pragma unroll
            for (int q = 0; q < 4; ++q) wv[tg][q] = *(const u32x4*)(vbase + (size_t)(4 * tg) * DIN + q * 128);
        const float* lgp = p.gm_ln_g + l * BW + h * 128 + lc * 8; const float* lbp = p.gm_ln_b + l * BW + h * 128 + lc * 8;
        const f32x4 g0 = *(const f32x4*)lgp, g1 = *(const f32x4*)(lgp + 4), b0 = *(const f32x4*)lbp, b1 = *(const f32x4*)(lbp + 4);
#pragma unroll
        for (int tg = 0; tg < 4; ++tg) {
            float s1 = 0.f, s2 = 0.f;
#pragma unroll
            for (int q = 0; q < 4; ++q) { const u32x4 w = wv[tg][q];
                const float a0 = bflo(w.x), a1 = bfhi(w.x), a2 = bflo(w.y), a3 = bfhi(w.y), a4 = bflo(w.z), a5 = bfhi(w.z), a6 = bflo(w.w), a7 = bfhi(w.w);
                s1 += ((a0 + a1) + (a2 + a3)) + ((a4 + a5) + (a6 + a7)); s2 += ((a0 * a0 + a1 * a1) + (a2 * a2 + a3 * a3)) + ((a4 * a4 + a5 * a5) + (a6 * a6 + a7 * a7)); }
#pragma unroll
            for (int o = 1; o < 16; o <<= 1) { s1 += __shfl_xor(s1, o); s2 += __shfl_xor(s2, o); }
            const float mean = s1 * (1.0f / 512.0f), var = fmaxf(s2 * (1.0f / 512.0f) - mean * mean, 0.f), rstd = 1.0f / sqrtf(var + EPS);
            const u32x4 w = (h == 0) ? wv[tg][0] : (h == 1) ? wv[tg][1] : (h == 2) ? wv[tg][2] : wv[tg][3];
            u32x4 o; o.x = cvt_pk_bf16((bflo(w.x) - mean) * rstd * g0[0] + b0[0], (bfhi(w.x) - mean) * rstd * g0[1] + b0[1]);
            o.y = cvt_pk_bf16((bflo(w.y) - mean) * rstd * g0[2] + b0[2], (bfhi(w.y) - mean) * rstd * g0[3] + b0[3]);
            o.z = cvt_pk_bf16((bflo(w.z) - mean) * rstd * g1[0] + b1[0], (bfhi(w.z) - mean) * rstd * g1[1] + b1[1]);
            o.w = cvt_pk_bf16((bflo(w.w) - mean) * rstd * g1[2] + b1[2], (bfhi(w.w) - mean) * rstd * g1[3] + b1[3]);
            *(LAS u32x4*)(lds + (16 * wave + 4 * tg + lg) * VP + lc * 16) = o; }
    }
    const int tt = 16 * wave + fr; const bf16_t* wsr = (const bf16_t*)(p.ws + WS_GMWS) + ((size_t)(l * 4 + h) * 128 + tt) * 128 + 8 * fq;
    const int jn = (wave >> 1) + 1;
    bf16x8 wf[4];
#pragma unroll
    for (int j = 0; j < 4; ++j) wf[j] = *(const bf16x8*)(wsr + 32 * j);
    bf16_t* up = proj + (size_t)(t0 + tt) * DIN + C_AU + h * 128 + 4 * fq; const bf16_t* gp = up + (C_AG - C_AU);
    u32x2 uu[8], gg[8];
#pragma unroll
    for (int et = 0; et < 8; ++et) { uu[et] = *(const u32x2*)(up + 16 * et); gg[et] = *(const u32x2*)(gp + 16 * et); }
    const float bs = p.gm_bs[(l * 4 + h) * 128 + tt];
    __syncthreads();
    f32x4 d[8];
#pragma unroll
    for (int et = 0; et < 8; ++et) d[et] = (f32x4){0.f, 0.f, 0.f, 0.f};
    const LAS unsigned char* vb = lds + (8 * fq + (fr >> 2)) * VP + (fr & 3) * 8;
#pragma unroll
    for (int j = 0; j < 4; ++j) { if (j < jn) {
#pragma unroll
        for (int et = 0; et < 8; ++et) { const s16x4 v0 = vtr(vb + (32 * j) * VP + et * 32), v1 = vtr(vb + (32 * j + 4) * VP + et * 32);
            d[et] = __builtin_amdgcn_mfma_f32_16x16x32_bf16(cat8(v0, v1), wf[j], d[et], 0, 0, 0); } } }
#pragma unroll
    for (int et = 0; et < 8; ++et) { const u32x2 u = uu[et], g = gg[et]; u32x2 w;
        w.x = cvt_pk_bf16(bflo(u.x) * (d[et][0] + bs) * bflo(g.x), bfhi(u.x) * (d[et][1] + bs) * bfhi(g.x));
        w.y = cvt_pk_bf16(bflo(u.y) * (d[et][2] + bs) * bflo(g.y), bfhi(u.y) * (d[et][3] + bs) * bfhi(g.y)); *(u32x2*)(up + 16 * et) = w; }
    __syncthreads();
}

constexpr int POOL_D_OFF = 40960;
__device__ __forceinline__ void pool_item(const Params& p, int l, int idx, LAS unsigned char* lds, int tid, int wave, int lane) {
    bf16_t* proj = (bf16_t*)(p.ws + WS_PROJ);
    const int g = idx & 3, c = idx >> 2, t0 = c * 128, win = 2 << g, pos0 = t0 & (SEQ - 1);
    const int fr = lane & 15, fq = lane >> 4;
    const bf16_t* wt = (const bf16_t*)(p.ws + WS_POOLW) + (size_t)(l * 4 + g) * 128 * 128 + fr * 128 + 8 * fq;
    bf16x8 wfr[8][4];
#pragma unroll
    for (int ot = 0; ot < 8; ++ot)
#pragma unroll
        for (int j = 0; j < 4; ++j) wfr[ot][j] = *(const bf16x8*)(wt + (size_t)(16 * ot) * 128 + 32 * j);
    {
        const bf16_t* pin = proj + C_PI + g * 128;
#pragma unroll
        for (int k = 0; k < 5; ++k) { const int cidx = tid + k * NTHREADS; if (cidx < 143 * 16) { const int rr = cidx >> 4, ch = cidx & 15;
            u32x4 w = (u32x4){0u, 0u, 0u, 0u}; if (pos0 - 15 + rr >= 0) w = *(const u32x4*)(pin + (size_t)(t0 - 15 + rr) * DIN + ch * 8);
            *(LAS u32x4*)(lds + rr * KP + ch * 16) = w; } }
    }
    __syncthreads();
    {
        const int t = tid >> 2, part = tid & 3, pos = pos0 + t; const int cnt = (pos + 1 < win) ? pos + 1 : win;
        float a[32];
#pragma unroll
        for (int i = 0; i < 32; ++i) a[i] = 0.f;
        const LAS unsigned char* rp = lds + (t + 15) * KP + part * 64;
        for (int jj = 0; jj < win; ++jj) {
#pragma unroll
            for (int i = 0; i < 4; ++i) { const u32x4 w = *(const LAS u32x4*)(rp - jj * KP + i * 16);
                a[i * 8 + 0] += bflo(w.x); a[i * 8 + 1] += bfhi(w.x); a[i * 8 + 2] += bflo(w.y); a[i * 8 + 3] += bfhi(w.y); a[i * 8 + 4] += bflo(w.z); a[i * 8 + 5] += bfhi(w.z); a[i * 8 + 6] += bflo(w.w); a[i * 8 + 7] += bfhi(w.w); } }
        const float ic = 1.0f / (float)cnt;
#pragma unroll
        for (int i = 0; i < 4; ++i) { const u32x4 w = *(const LAS u32x4*)(rp + i * 16); u32x4 o;
            o.x = cvt_pk_bf16(a[i * 8 + 0] * ic - bflo(w.x), a[i * 8 + 1] * ic - bfhi(w.x)); o.y = cvt_pk_bf16(a[i * 8 + 2] * ic - bflo(w.y), a[i * 8 + 3] * ic - bfhi(w.y));
            o.z = cvt_pk_bf16(a[i * 8 + 4] * ic - bflo(w.z), a[i * 8 + 5] * ic - bfhi(w.z)); o.w = cvt_pk_bf16(a[i * 8 + 6] * ic - bflo(w.w), a[i * 8 + 7] * ic - bfhi(w.w));
            *(LAS u32x4*)(lds + POOL_D_OFF + t * KP + (part * 32 + i * 8) * 2) = o; }
    }
    __syncthreads();
    const int tt = 16 * wave + fr;
    bf16x8 df[4];
#pragma unroll
    for (int j = 0; j < 4; ++j) df[j] = *(const LAS bf16x8*)(lds + POOL_D_OFF + tt * KP + (32 * j + 8 * fq) * 2);
    const float* sc = p.pool_scale + l * BW + g * 128 + 4 * fq;
    bf16_t* gp = proj + (size_t)(t0 + tt) * DIN + C_PG + g * 128 + 4 * fq;
    u32x2 gtv[8];
#pragma unroll
    for (int ot = 0; ot < 8; ++ot) gtv[ot] = *(const u32x2*)(gp + 16 * ot);
    asm volatile("" ::: "memory");
#pragma unroll
    for (int ot = 0; ot < 8; ++ot) {
        f32x4 d = (f32x4){0.f, 0.f, 0.f, 0.f};
#pragma unroll
        for (int j = 0; j < 4; ++j) d = __builtin_amdgcn_mfma_f32_16x16x32_bf16(wfr[ot][j], df[j], d, 0, 0, 0);
        const f32x4 s4 = *(const f32x4*)(sc + 16 * ot); const u32x2 gt = gtv[ot]; u32x2 w;
        w.x = cvt_pk_bf16(d[0] * s4[0] * bflo(gt.x), d[1] * s4[1] * bfhi(gt.x)); w.y = cvt_pk_bf16(d[2] * s4[2] * bflo(gt.y), d[3] * s4[3] * bfhi(gt.y));
        *(u32x2*)(gp + 16 * ot) = w;
    }
    __syncthreads();
}

__device__ __forceinline__ void combine_phase(const Params& p, int gtid, int ngt) {
    bf16_t* proj = (bf16_t*)(p.ws + WS_PROJ); const bf16_t* og = (const bf16_t*)(p.ws + WS_OG); const float* lse = (const float*)(p.ws + WS_LSE);
    for (int i0 = gtid; i0 < NTOK * 64; i0 += 8 * ngt) {
        float l0[8], l1[8], l2[8]; u32x4 o0[8], o1[8], o2[8], g[8];
#pragma unroll
        for (int k = 0; k < 8; ++k) { int i = i0 + k * ngt; if (i >= NTOK * 64) i = i0; const int t = i >> 6, ch = (i & 63) * 8, h = ch >> 7;
            const int b = t >> 12, pos = t & (SEQ - 1);
            l0[k] = lse[((size_t)(0 * 512) + ((b * 32 + (pos >> 7)) * 4 + h)) * 128 + (pos & 127)];
            l1[k] = lse[((size_t)(1 * 512) + (((b * 4 + (pos & 3)) * 8 + (pos >> 9)) * 4 + h)) * 128 + ((pos >> 2) & 127)];
            l2[k] = lse[((size_t)(2 * 512) + (((b * 16 + (pos & 15)) * 2 + (pos >> 11)) * 4 + h)) * 128 + ((pos >> 4) & 127)];
            o0[k] = *(const u32x4*)(og + (size_t)t * BW + ch); o1[k] = *(const u32x4*)(og + ((size_t)NTOK + t) * BW + ch); o2[k] = *(const u32x4*)(og + ((size_t)2 * NTOK + t) * BW + ch);
            g[k] = *(const u32x4*)(proj + (size_t)t * DIN + C_CG + ch); }
        asm volatile("" ::: "memory");
#pragma unroll
        for (int k = 0; k < 8; ++k) { const int i = i0 + k * ngt; if (i >= NTOK * 64) continue; const int t = i >> 6, ch = (i & 63) * 8;
            const float mx = fmaxf(l0[k], fmaxf(l1[k], l2[k])); float a0 = fast_exp2(l0[k] - mx), a1 = fast_exp2(l1[k] - mx), a2 = fast_exp2(l2[k] - mx); const float inv = fast_rcp(a0 + a1 + a2); a0 *= inv; a1 *= inv; a2 *= inv;
            u32x4 w;
#define CMB(f) w.f = cvt_pk_bf16((a0 * bflo(o0[k].f) + a1 * bflo(o1[k].f) + a2 * bflo(o2[k].f)) * bflo(g[k].f), (a0 * bfhi(o0[k].f) + a1 * bfhi(o1[k].f) + a2 * bfhi(o2[k].f)) * bfhi(g[k].f))
            CMB(x); CMB(y); CMB(z); CMB(w);
#undef CMB
            *(u32x4*)(proj + (size_t)t * DIN + C_CG + ch) = w; }
    }
}

#define RLX_AGENT __ATOMIC_RELAXED, __HIP_MEMORY_SCOPE_AGENT
#define XB_TMO      128
#define XB_XCNT(j)  (256  + 64 * (j))
#define XB_XSUB(j)  (1280 + 64 * (j))
#define XB_XGEN(j)  (2304 + 64 * (j))
#define XB_TOP      3328
#define XB_TOPGEN   3392
#define XCD_BAR_WORDS 3456
#define XB_SPIN_CAP (1u << 18)

__device__ __forceinline__ unsigned xb_ld(unsigned* p)              { return __hip_atomic_load(p, __ATOMIC_RELAXED, __HIP_MEMORY_SCOPE_AGENT); }
__device__ __forceinline__ unsigned xb_add(unsigned* p, unsigned v) { return __hip_atomic_fetch_add(p, v, __ATOMIC_RELAXED, __HIP_MEMORY_SCOPE_AGENT); }
__device__ __forceinline__ unsigned xb_xcc_id() { return (unsigned)__builtin_amdgcn_s_getreg((3 << 11) | 20) & 0xFu; }
#define XB_SPIN(cond, bar) do { unsigned _sp = 0; while (cond) { __builtin_amdgcn_s_sleep(1); \
    if ((++_sp & 255u) == 0u) { if (xb_ld(&(bar)[XB_TMO])) break; if (_sp > XB_SPIN_CAP) { atomicAdd(&(bar)[XB_TMO], 1u); break; } } } } while (0)

struct XcdBarrier {
    unsigned* bar; unsigned x;
    volatile LAS unsigned* st;
};

__device__ __forceinline__ XcdBarrier xcd_barrier_post(unsigned* bar, volatile LAS unsigned* st) {
    XcdBarrier b; b.bar = bar; b.x = xb_xcc_id(); b.st = st;
    if (threadIdx.x == 0) (void)xb_add(&bar[XB_XCNT(b.x)], 1u);
    return b;
}
__device__ __forceinline__ void xcd_barrier_complete(unsigned* bar, unsigned x, unsigned& nloc, unsigned& nx) {
    const unsigned G = gridDim.x * gridDim.y * gridDim.z;
    unsigned sum, cnt, mine, sp = 0u;
    for (;;) {
        sum = 0u; cnt = 0u; mine = 0u;
#pragma unroll
        for (unsigned j = 0; j < 16; ++j) { const unsigned c = xb_ld(&bar[XB_XCNT(j)]); sum += c; cnt += (c > 0u) ? 1u : 0u; mine = (j == x) ? c : mine; }
        if (sum == G) break;
        __builtin_amdgcn_s_sleep(1);
        if ((++sp & 255u) == 0u) { if (xb_ld(&bar[XB_TMO])) break; if (sp > XB_SPIN_CAP) { atomicAdd(&bar[XB_TMO], 1u); break; } }
    }
    nloc = mine > 0u ? mine : 1u; nx = cnt > 0u ? cnt : 1u;
}

__device__ __forceinline__ void xcd_barrier(const XcdBarrier& b) {
    asm volatile("s_waitcnt vmcnt(0)" ::: "memory");
    __syncthreads();
    if (threadIdx.x == 0) {
        unsigned* bar = b.bar;
        __builtin_amdgcn_s_waitcnt(0);
        unsigned nloc = b.st[0], nx = b.st[1];
        if (nloc == 0u) { xcd_barrier_complete(bar, b.x, nloc, nx); b.st[0] = nloc; b.st[1] = nx; }
        const unsigned old = xb_add(&bar[XB_XSUB(b.x)], 1u);
        const unsigned gen = old / nloc;
        if (old + 1u == (gen + 1u) * nloc) {
            __builtin_amdgcn_fence(__ATOMIC_RELEASE, "agent");
            asm volatile("s_waitcnt vmcnt(0)" ::: "memory");
            const unsigned og = xb_add(&bar[XB_TOP], 1u);
            const unsigned tg = og / nx;
            if (og + 1u == (tg + 1u) * nx) xb_add(&bar[XB_TOPGEN], 1u);
            else XB_SPIN(xb_ld(&bar[XB_TOPGEN]) == tg, bar);
            __builtin_amdgcn_fence(__ATOMIC_ACQUIRE, "agent");
            xb_add(&bar[XB_XGEN(b.x)], 1u);
            asm volatile("s_waitcnt vmcnt(0)" ::: "memory");
        } else {
            XB_SPIN(xb_ld(&bar[XB_XGEN(b.x)]) == gen, bar);
            __builtin_amdgcn_fence(__ATOMIC_ACQUIRE, "agent");
            asm volatile("s_waitcnt vmcnt(0)" ::: "memory");
        }
    }
    __syncthreads();
}

#ifndef IT_MASK
#define IT_MASK 15
#endif
#ifndef PH_MASK
#define PH_MASK 31
#endif
__global__ void __launch_bounds__(NTHREADS, 2) mega_fwd(Params p) {
    extern __shared__ __attribute__((aligned(16))) unsigned char lds_raw[];
    LAS unsigned char* lds = (LAS unsigned char*)lds_raw;
    cg::grid_group grid = cg::this_grid();
    const int tid = threadIdx.x, lane = tid & 63, wave = __builtin_amdgcn_readfirstlane(tid >> 6);
    const int G = gridDim.x, bx = blockIdx.x;
    const int vcu = (G % 8 == 0) ? (bx % 8) * (G / 8) + bx / 8 : bx;
    unsigned char* ws = p.ws;
    bf16_t* proj = (bf16_t*)(ws + WS_PROJ);
    volatile LAS unsigned* xst = (volatile LAS unsigned*)(lds + LDS_BYTES - 64);
    if (tid < 16) xst[tid] = 0u;
    __syncthreads();
    (void)xcd_barrier_post((unsigned*)(ws + WS_CTL), xst);
    grid.sync();

    prologue(p, lds, vcu, G, wave, lane);
    { XcdBarrier xb_; xb_.bar = (unsigned*)(p.ws + WS_CTL); xb_.x = xb_xcc_id(); xb_.st = (volatile LAS unsigned*)(lds + LDS_BYTES - 64); xcd_barrier(xb_); }

    for (int l = 0; l < DEPTH; ++l) {
#if PH_MASK & 1
        { int tidp = threadIdx.x; asm volatile("" : "+v"(tidp));
        if (l == 0) {
            pg8::Gemm g{(const bf16_t*)(ws + WS_MEMB), (const bf16_t*)(ws + WS_WKV), DM, DM, DM};
            pg8::StaticOrder S; S.init(NB * MEMLEN, DEPTH * DM, G, (bx + G / 2) % G);
            pg8::EpiProj E{(bf16_t*)(ws + WS_MEMKV), DEPTH * DM, (const float*)(ws + WS_MEMSS), 1, 1.0f};
            pg8::gemm_phase<pg8::EpiProj, pg8::StaticOrder, true, true>(lds, g, S, E, tidp);
        }
        {
            pg8::Gemm g{(const bf16_t*)(ws + WS_XB8), (const bf16_t*)(ws + WS_WG8 + (size_t)l * DIN * DM), DM / 2, DM / 2, DM / 2};
            const int ntile = (NTOK / 256) * NT_FP8, full = ntile / G, rag = ntile - full * G;
            const bool halves = (l > 0) && (G % 2 == 0) && rag > 0 && rag <= G / 2;
            pg8::GateOrder S; S.base.init(NTOK, NT_FP8 * 256, G, bx); S.rounds = halves ? full : full + 1;
            pg8::EpiProj E{proj, DIN, (const float*)(ws + WS_ROWSS) + (size_t)l * NTOK, 0, 1.0f / WG8_SCALE};
            pg8::gemm_phase<pg8::EpiProj, pg8::GateOrder, true, true, false, true>(lds, g, S, E, tidp);
            if (halves) {
                pg8::ProjHalfOrder H; H.base.init(NTOK, NT_FP8 * 256, G, bx % (G / 2)); H.round = full; H.half = bx / (G / 2); H.hbytes = (long)128 * (DM / 2) * 2;
                pg8::EpiProjT<true> EH{proj, DIN, (const float*)(ws + WS_ROWSS) + (size_t)l * NTOK, 0, 1.0f / WG8_SCALE};
                pg8::gemm_phase<pg8::EpiProjT<true>, pg8::ProjHalfOrder, true, true, true, true>(lds, g, H, EH, tidp);
            }
        }
        {
            pg8::Gemm g{(const bf16_t*)(ws + WS_XB), (const bf16_t*)(ws + WS_WIN) + (size_t)l * DIN * DM, DM, DM, DM};
            pg8::ProjOrder S; S.base.init(NTOK, NT_BF16 * 256, G, bx); S.rounds = 1 << 20;
            pg8::EpiProj E{proj, DIN, (const float*)(ws + WS_ROWSS) + (size_t)l * NTOK, 0, 1.0f};
            pg8::gemm_phase<pg8::EpiProj, pg8::ProjOrder, true, true>(lds, g, S, E, tidp);
        }
        }
#endif
        { XcdBarrier xb_; xb_.bar = (unsigned*)(p.ws + WS_CTL); xb_.x = xb_xcc_id(); xb_.st = (volatile LAS unsigned*)(lds + LDS_BYTES - 64); xcd_barrier(xb_); }
#if PH_MASK & 2
        if (G == 256) {
            const int x = bx & 7, m = (bx >> 3) & 31;
            for (int k = 0; k < 2; ++k) { int tidp = threadIdx.x; asm volatile("" : "+v"(tidp)); const int lanep = tidp & 63, wavep = __builtin_amdgcn_readfirstlane(tidp >> 6);
                gmlp_item(p, l, (((k * 8 + x) * 8 + (m >> 2)) << 2) | (m & 3), lds, tidp, wavep, lanep); }
            for (int k = 0; k < 2; ++k) { int tidp = threadIdx.x; asm volatile("" : "+v"(tidp)); const int lanep = tidp & 63, wavep = __builtin_amdgcn_readfirstlane(tidp >> 6);
                const int j = bx + 256 * k; pool_item(p, l, k ? ((j & ~3) | (3 - (j & 3))) : j, lds, tidp, wavep, lanep); }
            for (int r = 0; r < 8; ++r) { int tidp = threadIdx.x; asm volatile("" : "+v"(tidp)); const int lanep = tidp & 63, wavep = __builtin_amdgcn_readfirstlane(tidp >> 6);
                const int idx = ((32 * ((x >> 2) + 2 * (r & 1)) + m) << 2) | (x & 3);
                if (r < 2) attn_item<0>(p, l, idx, lds, tidp, wavep, lanep); else if (r < 4) attn_item<1>(p, l, idx, lds, tidp, wavep, lanep);
                else if (r < 6) attn_item<2>(p, l, idx, lds, tidp, wavep, lanep); else attn_item<3>(p, l, idx, lds, tidp, wavep, lanep); }
        } else
        for (int it = bx; it < 3072; it += G) {
            int tidp = threadIdx.x; asm volatile("" : "+v"(tidp)); const int lanep = tidp & 63, wavep = __builtin_amdgcn_readfirstlane(tidp >> 6);
            const int cls = it >> 9, idx = it & 511;
            if (cls == 0) gmlp_item(p, l, idx, lds, tidp, wavep, lanep);
            else if (cls == 1) pool_item(p, l, idx, lds, tidp, wavep, lanep);
            else if (cls == 2) attn_item<0>(p, l, idx, lds, tidp, wavep, lanep);
            else if (cls == 3) attn_item<1>(p, l, idx, lds, tidp, wavep, lanep);
            else if (cls == 4) attn_item<2>(p, l, idx, lds, tidp, wavep, lanep);
            else attn_item<3>(p, l, idx, lds, tidp, wavep, lanep);
        }
#endif
        { XcdBarrier xb_; xb_.bar = (unsigned*)(p.ws + WS_CTL); xb_.x = xb_xcc_id(); xb_.st = (volatile LAS unsigned*)(lds + LDS_BYTES - 64); xcd_barrier(xb_); }
#if PH_MASK & 4
        { int tidp = threadIdx.x; asm volatile("" : "+v"(tidp)); combine_phase(p, bx * NTHREADS + tidp, G * NTHREADS); }
#endif
        { XcdBarrier xb_; xb_.bar = (unsigned*)(p.ws + WS_CTL); xb_.x = xb_xcc_id(); xb_.st = (volatile LAS unsigned*)(lds + LDS_BYTES - 64); xcd_barrier(xb_); }
#if PH_MASK & 8
        { int tidp = threadIdx.x; asm volatile("" : "+v"(tidp));
            pg8::Gemm g{proj, (const bf16_t*)(ws + WS_WBR) + (size_t)l * 4 * DM * BW, DIN, BW, BW};
            pg8::MergeOrder S; S.base.init(NTOK, DM, G, bx); S.bstep = (long)DM * BW * 2; S.a0 = C_AU * 2; S.a1 = C_PG * 2; S.a2 = C_CG * 2; S.a3 = C_MG * 2; S.astep = 0;
            pg8::EpiMerge E{proj + C_GM, DIN, (bf16_t*)(ws + WS_Z)};
            pg8::gemm_phase<pg8::EpiMerge, pg8::MergeOrder, true, true>(lds, g, S, E, tidp);
        }
#endif
        { XcdBarrier xb_; xb_.bar = (unsigned*)(p.ws + WS_CTL); xb_.x = xb_xcc_id(); xb_.st = (volatile LAS unsigned*)(lds + LDS_BYTES - 64); xcd_barrier(xb_); }
#if PH_MASK & 16
        { int tidp = threadIdx.x; asm volatile("" : "+v"(tidp));
            pg8::Gemm g{(const bf16_t*)(ws + WS_Z), (const bf16_t*)(ws + WS_WOUT) + (size_t)l * DM * DM, DM, DM, DM};
            pg8::StaticOrder S; S.init(NTOK, DM, G, bx);
            pg8::EpiOut E{l == 0 ? p.x : p.out, p.out, (bf16_t*)(ws + WS_XB), (float*)(ws + WS_ROWSS) + (size_t)(l + 1) * NTOK, ws + WS_XB8, l < DEPTH - 1};
            pg8::gemm_phase<pg8::EpiOut, pg8::StaticOrder, true, true>(lds, g, S, E, tidp);
        }
#endif
        { XcdBarrier xb_; xb_.bar = (unsigned*)(p.ws + WS_CTL); xb_.x = xb_xcc_id(); xb_.st = (volatile LAS unsigned*)(lds + LDS_BYTES - 64); xcd_barrier(xb_); }
    }
    {
        int tidf = threadIdx.x; asm volatile("" : "+v"(tidf)); const int lane = tidf & 63, wave = __builtin_amdgcn_readfirstlane(tidf >> 6);
        const int gw = vcu * NWAVES + wave, NGW = G * NWAVES; const float* ss = (const float*)(ws + WS_ROWSS) + (size_t)DEPTH * NTOK;
        f32x4 gg[4];
#pragma unroll
        for (int j = 0; j < 4; ++j) gg[j] = ((const f32x4*)p.final_norm_g)[lane + 64 * j];
        for (int m0 = gw; m0 < NTOK; m0 += 4 * NGW) {
            f32x4 v[4][4]; float sq[4];
#pragma unroll
            for (int i = 0; i < 4; ++i) { int m = m0 + i * NGW; if (m >= NTOK) m = m0; sq[i] = ss[m]; const f32x4* xr = (const f32x4*)(p.out + (size_t)m * DM) + lane;
#pragma unroll
                for (int j = 0; j < 4; ++j) v[i][j] = xr[64 * j]; }
            asm volatile("" ::: "memory");
#pragma unroll
            for (int i = 0; i < 4; ++i) { const int m = m0 + i * NGW; if (m >= NTOK) continue; const float rs = 1.0f / sqrtf(sq[i] * (1.0f / 1024.0f) + EPS); f32x4* xr = (f32x4*)(p.out + (size_t)m * DM) + lane;
#pragma unroll
                for (int j = 0; j < 4; ++j) xr[64 * j] = v[i][j] * rs * gg[j]; }
            asm volatile("" ::: "memory");
        }
    }
}

extern "C" void kernel_launch(void* const* d_in, const int* in_sizes, int n_in, void* d_out, int out_size, void* d_ws, size_t ws_size, hipStream_t stream) {
    static int grid = 0;
    if (grid == 0) {
        if (n_in != 15 || in_sizes[0] != NTOK * DM || out_size != NTOK * DM || ws_size < WS_END) { fprintf(stderr, "kernel_launch: unexpected shapes (n_in %d, in0 %d, out %d, ws %zu, need %zu)\n", n_in, n_in > 0 ? in_sizes[0] : -1, out_size, ws_size, (size_t)WS_END); grid = -1; return; }
        int dev = 0, cus = 0, per_cu = 0;
        hipGetDevice(&dev); hipDeviceGetAttribute(&cus, hipDeviceAttributeMultiprocessorCount, dev);
        if (hipFuncSetAttribute((const void*)mega_fwd, hipFuncAttributeMaxDynamicSharedMemorySize, LDS_BYTES) != hipSuccess) { fprintf(stderr, "kernel_launch: hipFuncSetAttribute failed\n"); grid = -1; return; }
        if (hipOccupancyMaxActiveBlocksPerMultiprocessor(&per_cu, (const void*)mega_fwd, NTHREADS, LDS_BYTES) != hipSuccess || per_cu < 1) { fprintf(stderr, "kernel_launch: occupancy query says %d blocks/CU\n", per_cu); grid = -1; return; }
        (void)hipGetLastError();
        grid = cus;
    }
    if (grid < 0) return;
    if (hipMemsetAsync((char*)d_ws + WS_CTL, 0, 16384, stream) != hipSuccess) { fprintf(stderr, "kernel_launch: memset failed\n"); return; }
    Params p{};
    p.x = (const float*)d_in[0]; p.mem = (const float*)d_in[1]; p.norm_g = (const float*)d_in[2]; p.w_in = (const float*)d_in[3]; p.gm_ln_g = (const float*)d_in[4]; p.gm_ln_b = (const float*)d_in[5];
    p.gm_ws = (const float*)d_in[6]; p.gm_bs = (const float*)d_in[7]; p.pool_w = (const float*)d_in[8]; p.pool_scale = (const float*)d_in[9]; p.mem_norm_g = (const float*)d_in[10];
    p.w_mem_kv = (const float*)d_in[11]; p.w_branch = (const float*)d_in[12]; p.w_out = (const float*)d_in[13]; p.final_norm_g = (const float*)d_in[14];
    p.out = (float*)d_out; p.ws = (unsigned char*)d_ws;
    void* args[] = {&p};
    hipError_t e = hipLaunchCooperativeKernel((const void*)mega_fwd, dim3(grid), dim3(NTHREADS), args, LDS_BYTES, stream);
    if (e != hipSuccess) fprintf(stderr, "kernel_launch: cooperative launch failed: %s (grid %d)\n", hipGetErrorString(e), grid);
}
```

```cpp
#include <hip/hip_runtime.h>
#include <hip/hip_cooperative_groups.h>
#include <cstdio>
#include <cstdint>
namespace cg = cooperative_groups;

#define LAS __attribute__((address_space(3)))
typedef unsigned short bf16_t;
typedef short bf16x8 __attribute__((ext_vector_type(8)));
typedef short s16x4 __attribute__((ext_vector_type(4)));
typedef float f32x4 __attribute__((ext_vector_type(4)));
typedef float f32x2 __attribute__((ext_vector_type(2)));
typedef unsigned u32x4 __attribute__((ext_vector_type(4)));
typedef unsigned u32x2 __attribute__((ext_vector_type(2)));

constexpr int NTOK = 16384, DM = 1024, DIN = 10752, BW = 512, SEQ = 4096, NB = 4, DEPTH = 4, MEMLEN = 256;
constexpr int C_AU = 0, C_AV = 512, C_AG = 1024, C_PI = 1536, C_PG = 2048, C_CQ = 2560, C_CK = 4096, C_CV = 4608, C_CG = 5120, C_MQ = 5632, C_MG = 6144, C_GM = 6656;
constexpr float EPS = 1e-6f;
constexpr int NGATE = 4096, NMIX = DIN - NGATE;
__host__ __device__ constexpr bool is_fp8_tile(int pn) { return (pn >= 10 && pn < 18) || (pn >= 20 && pn < 30) || pn >= 34; }
constexpr int NT_FP8 = 26, NT_BF16 = 16;
constexpr float WG8_SCALE = 64.0f;
constexpr float QSCALE = 0.08838834764831845f * 1.4426950408889634f;

constexpr size_t MiB = 1u << 20;
constexpr size_t WS_WIN = 0, WS_WBR = 84 * MiB, WS_WOUT = 100 * MiB, WS_WKV = 108 * MiB, WS_POOLW = 116 * MiB, WS_GMWS = 116 * MiB + 512 * 1024;
constexpr size_t WS_XB = 117 * MiB, WS_MEMB = 149 * MiB, WS_MEMKV = 151 * MiB, WS_ROWSS = 159 * MiB, WS_MEMSS = 159 * MiB + 512 * 1024, WS_LSE = 160 * MiB;
constexpr size_t WS_OG = 161 * MiB, WS_ZF = 209 * MiB, WS_XB8 = 209 * MiB  , WS_WG8 = 225 * MiB  , WS_PROJ = 273 * MiB, WS_Z = 609 * MiB, WS_CTL = 641 * MiB, WS_END = 642 * MiB;
constexpr int LDS_BYTES = 147456;

__device__ __forceinline__ float bflo(unsigned w) { return __uint_as_float(w << 16); }
__device__ __forceinline__ float bfhi(unsigned w) { return __uint_as_float(w & 0xffff0000u); }
__device__ __forceinline__ unsigned cvt_pk_bf16(float lo, float hi) { unsigned r; asm("v_cvt_pk_bf16_f32 %0, %1, %2" : "=v"(r) : "v"(lo), "v"(hi)); return r; }
__device__ __forceinline__ float fast_rcp(float x) { return __builtin_amdgcn_rcpf(x); }
__device__ __forceinline__ float fast_exp2(float x) { return __builtin_amdgcn_exp2f(x); }
__device__ __forceinline__ float sigmoidf_(float x) { return fast_rcp(1.0f + fast_exp2(-1.4426950408889634f * x)); }
__device__ __forceinline__ float siluf_(float x) { return x * sigmoidf_(x); }
__device__ __forceinline__ float geluf_(float v) {
    const float av = __builtin_fabsf(v), d = av * 0.2316418882f + 1.0f, t = fast_rcp(d);
    float q = t * 0.5307027145f + (-0.7265760135f); q = q * t + 0.7107068705f; q = q * t + (-0.142248368f); q = q * t + 0.127414796f; q = q * t;
    const float e = fast_exp2((v * v) * (-0.72134752044f));
    const float m = v * (q * e), r = v - m;
    return v < 0.f ? m : r;
}
namespace pg8 {
#define PG8_LAS __attribute__((address_space(3)))
constexpr int BM = 256, BK = 64, HALF = 128, HALF_ROWS = 128, HTB = HALF * BK * 2  , STAGE_BYTES = 8 * HTB, NXCD = 8, WGM = 8;

__host__ __device__ __forceinline__ int lds_byte(int r, int c) { const int st = (r >> 4) * 2 + (c >> 5), rr = r & 15, cc = c & 31, ob = rr * 64 + cc * 2; return st * 1024 + (ob ^ (((ob >> 9) & 1) << 5)); }
__host__ __device__ __forceinline__ void stage_rc(int b, int& R, int& C) { const int st = b / 1024, sb = b % 1024, swz = sb ^ (((sb >> 9) & 1) << 5); R = (st >> 1) * 16 + swz / 64; C = (st & 1) * 32 + (swz % 64) / 2; }
__host__ __device__ __forceinline__ int perm32(int rho) { const int n = rho >> 4, i = rho & 15; return 8 * (i >> 2) + 4 * n + (i & 3); }

typedef int i32x4 __attribute__((ext_vector_type(4))); typedef int i32x8 __attribute__((ext_vector_type(8)));
__device__ __forceinline__ i32x8 cat8i(bf16x8 a, bf16x8 b) { return __builtin_shufflevector(__builtin_bit_cast(i32x4, a), __builtin_bit_cast(i32x4, b), 0, 1, 2, 3, 4, 5, 6, 7); }
struct Unit { int pm, pn, z; long aoff, boff; };
struct Gemm { const bf16_t* A; const bf16_t* Bt; int lda, ldb, K; };

struct StaticOrder {
    int nM, nN, nwg, G, c;
    __host__ __device__ void init(int M, int N, int G_, int c_) { nM = M / BM; nN = N / BM; nwg = nM * nN; G = G_; c = c_; }
    __host__ __device__ bool next(int i, Unit& u) const {
        const long L = (long)i * G + c; if (L >= nwg) return false;
        int wgid = (int)L; { const int q = nwg / NXCD, r = nwg % NXCD, xcd = wgid % NXCD, off = wgid / NXCD; wgid = (xcd < r ? xcd * (q + 1) : r * (q + 1) + (xcd - r) * q) + off; }
        const int nig = WGM * nN, gid = wgid / nig, fm = gid * WGM, gsz = (nM - fm) < WGM ? (nM - fm) : WGM;
        u.pm = fm + ((wgid % nig) % gsz); u.pn = (wgid % nig) / gsz; u.z = 0; u.aoff = 0; u.boff = 0; return true;
    }
};
__host__ __device__ __forceinline__ int fp8_tile(int j) { return j < 8 ? 10 + j : (j < 18 ? 12 + j : 16 + j); }
__host__ __device__ __forceinline__ int bf16_tile(int j) { return j < 10 ? j : (j < 12 ? 8 + j : 18 + j); }
struct ProjOrder {
    StaticOrder base; int rounds;
    __device__ bool next(int i, Unit& u) const { if (i >= rounds || !base.next(i, u)) return false; u.pn = bf16_tile(u.pn); return true; }
};
struct ProjHalfOrder {
    StaticOrder base; int round, half; long hbytes;
    __device__ bool next(int i, Unit& u) const { if (i > 0 || !base.next(round, u)) return false; u.pn = fp8_tile(u.pn); u.z = half; u.aoff = half * hbytes; return true; }
};
struct GateOrder {
    StaticOrder base; int rounds;
    __device__ bool next(int i, Unit& u) const { if (i >= rounds || !base.next(i, u)) return false; u.pn = fp8_tile(u.pn); return true; }
};
struct MergeOrder {
    StaticOrder base; long astep, bstep; long a0, a1, a2, a3;
    __device__ bool next(int i, Unit& u) const {
        if (!base.next(i >> 2, u)) return false;
        const int z = i & 3; u.z = z; u.aoff = (z == 0 ? a0 : z == 1 ? a1 : z == 2 ? a2 : a3); u.boff = bstep * z; return true;
    }
};

template <class Epi, class Sched, bool ALIGN_EPI = false, bool SP2 = false, bool HALF_M = false, bool FP8 = false>
__device__ __forceinline__ void gemm_phase(PG8_LAS unsigned char* lds, const Gemm g, const Sched& S, const Epi& E, int tid) {
    const int wid = __builtin_amdgcn_readfirstlane(tid >> 6), lane = tid & 63, wr = wid >> 2, wc = wid & 3, fr = lane & 15, fq = lane >> 4;
    const int K = g.K, nt = K / BK;
    unsigned voffA[2], voffB[2];
#pragma unroll
    for (int i = 0; i < 2; ++i) { int R, C; stage_rc(tid * 16 + i * 8192, R, C); const int Rb = Epi::PERM ? ((R & ~31) + perm32(R & 31)) : R;
        voffA[i] = (unsigned)(R * g.lda + C) * 2u; voffB[i] = (unsigned)(Rb * g.ldb + C) * 2u; }
    const size_t kstep = (size_t)(BK * 2);
    const size_t hstepA = (size_t)HALF * g.lda * 2, hstepB = (size_t)HALF * g.ldb * 2;
    const unsigned ldsw = (unsigned)wid * 1024u;
    const int aoff = lds_byte(wr * 64 + fr, fq * 8), boff = lds_byte(wc * 32 + fr, fq * 8);
#define PG8_SA(b, h) (((b) * 2 + (h)) * HTB)
#define PG8_SB(b, h) ((4 + (b) * 2 + (h)) * HTB)
#define PG8_STAGE(bufoff, gbase, voff) do { _Pragma("unroll") for (int _i = 0; _i < 2; ++_i) \
        __builtin_amdgcn_global_load_lds((const unsigned*)((const char*)(gbase) + (voff)[_i]), (PG8_LAS unsigned*)(lds + (bufoff) + ldsw + _i * 8192), 16, 0, 0); } while (0)
#define PG8_LDA(dst, b, h) do { _Pragma("unroll") for (int m = 0; m < 4; ++m) { if constexpr (FP8) dst##8[m] = cat8i(*(const PG8_LAS bf16x8*)(lds + PG8_SA(b, h) + aoff + m * 2048), *(const PG8_LAS bf16x8*)(lds + PG8_SA(b, h) + aoff + m * 2048 + 1024)); \
        else { _Pragma("unroll") for (int k = 0; k < 2; ++k) dst[m][k] = *(const PG8_LAS bf16x8*)(lds + PG8_SA(b, h) + aoff + m * 2048 + k * 1024); } } } while (0)
#define PG8_LDB(dst, b, h) do { _Pragma("unroll") for (int n = 0; n < 2; ++n) { if constexpr (FP8) dst##8[n] = cat8i(*(const PG8_LAS bf16x8*)(lds + PG8_SB(b, h) + boff + n * 2048), *(const PG8_LAS bf16x8*)(lds + PG8_SB(b, h) + boff + n * 2048 + 1024)); \
        else { _Pragma("unroll") for (int k = 0; k < 2; ++k) dst[n][k] = *(const PG8_LAS bf16x8*)(lds + PG8_SB(b, h) + boff + n * 2048 + k * 1024); } } } while (0)
#define PG8_MMA(ai, bj, At, Bt) do { __builtin_amdgcn_s_setprio(1); _Pragma("unroll") for (int m = 0; m < 4; ++m) _Pragma("unroll") for (int n = 0; n < 2; ++n) { \
        if constexpr (FP8) asm volatile("v_mfma_scale_f32_16x16x128_f8f6f4 %0, %1, %2, %0, %3, %3 op_sel_hi:[0,0,0]" : "+v"(acc[ai][bj][m][n]) : "v"(Bt##8[n]), "v"(At##8[m]), "v"(sc8));   \
        else { _Pragma("unroll") for (int k = 0; k < 2; ++k) acc[ai][bj][m][n] = __builtin_amdgcn_mfma_f32_16x16x32_bf16(Bt[n][k], At[m][k], acc[ai][bj][m][n], 0, 0, 0); } } \
        __builtin_amdgcn_s_setprio(0); } while (0)
#define PG8_WAIT_V(n) asm volatile("s_waitcnt vmcnt(" #n ")" ::: "memory")
#define PG8_WAIT_L(n) asm volatile("s_waitcnt lgkmcnt(" #n ")" ::: "memory")
#define PG8_BAR __builtin_amdgcn_s_barrier()
#define PG8_SCHED __builtin_amdgcn_sched_barrier(0)
    Unit cur, nxt; int ui = 0;
    if (!S.next(0, cur)) return;
    f32x4 acc[2][2][4][2];
#pragma unroll
    for (int a = 0; a < 2; ++a)
#pragma unroll
        for (int b = 0; b < 2; ++b)
#pragma unroll
            for (int m = 0; m < 4; ++m)
#pragma unroll
                for (int n = 0; n < 2; ++n) acc[a][b][m][n] = (f32x4){0.f, 0.f, 0.f, 0.f};
    bf16x8 At[4][2], B0[2][2], B1[2][2];
    const int sc8 = 0x7f7f7f7f;
    i32x8 At8[4], B08[2], B18[2];
    const char* cA = (const char*)g.A + (size_t)cur.pm * 2 * hstepA + cur.aoff; const char* cB = (const char*)g.Bt + (size_t)cur.pn * 2 * hstepB + cur.boff;
    if constexpr (SP2) {
        PG8_STAGE(PG8_SB(0, 0), cB, voffB); PG8_STAGE(PG8_SB(0, 1), cB + hstepB, voffB); PG8_STAGE(PG8_SA(0, 0), cA, voffA); PG8_STAGE(PG8_SA(0, 1), cA + hstepA, voffA);
        if (wr == 1) PG8_BAR;
        PG8_WAIT_V(2); PG8_BAR;
        PG8_STAGE(PG8_SB(1, 0), cB + kstep, voffB); PG8_STAGE(PG8_SA(1, 0), cA + kstep, voffA); PG8_STAGE(PG8_SB(1, 1), cB + hstepB + kstep, voffB);
        PG8_WAIT_V(6); PG8_BAR;
    } else {
        PG8_STAGE(PG8_SB(0, 0), cB, voffB); PG8_STAGE(PG8_SA(0, 0), cA, voffA); PG8_STAGE(PG8_SB(0, 1), cB + hstepB, voffB); PG8_STAGE(PG8_SA(0, 1), cA + hstepA, voffA);
        if (wr == 1) PG8_BAR;
        PG8_WAIT_V(4); PG8_BAR;
        PG8_STAGE(PG8_SB(1, 0), cB + kstep, voffB); PG8_STAGE(PG8_SA(1, 0), cA + kstep, voffA); PG8_STAGE(PG8_SB(1, 1), cB + hstepB + kstep, voffB);
        PG8_WAIT_V(6); PG8_BAR;
    }
    for (;;) {
        const bool has_next = S.next(ui + 1, nxt);
        const char* nA = has_next ? (const char*)g.A + (size_t)nxt.pm * 2 * hstepA + nxt.aoff : cA; const char* nB = has_next ? (const char*)g.Bt + (size_t)nxt.pn * 2 * hstepB + nxt.boff : cB;
        for (int t = 0; t < nt; t += 2) {
            const bool last = (t == nt - 2);
            const char* a1 = cA + (size_t)(t + 1) * kstep;
            const char* a2 = last ? nA : cA + (size_t)(t + 2) * kstep; const char* b2 = last ? nB : cB + (size_t)(t + 2) * kstep;
            const char* a3 = a2 + kstep; const char* b3 = b2 + kstep;
            if constexpr (SP2) {
            PG8_LDB(B0, 0, 0); PG8_LDB(B1, 0, 1); PG8_SCHED; PG8_LDA(At, 0, 0); PG8_STAGE(PG8_SA(1, 1), a1 + hstepA, voffA);
            PG8_WAIT_V(8); PG8_WAIT_L(0); PG8_BAR; PG8_MMA(0, 0, At, B0); PG8_MMA(0, 1, At, B1); PG8_BAR; PG8_SCHED;
            if constexpr (!HALF_M) PG8_LDA(At, 0, 1); PG8_STAGE(PG8_SB(0, 0), b2, voffB); PG8_STAGE(PG8_SB(0, 1), b2 + hstepB, voffB); PG8_STAGE(PG8_SA(0, 0), a2, voffA);
            PG8_WAIT_V(8); PG8_WAIT_L(0); PG8_BAR; if constexpr (!HALF_M) { PG8_MMA(1, 0, At, B0); PG8_MMA(1, 1, At, B1); } PG8_BAR; PG8_SCHED;
            PG8_LDB(B0, 1, 0); PG8_LDB(B1, 1, 1); PG8_SCHED; PG8_LDA(At, 1, 0); PG8_STAGE(PG8_SA(0, 1), a2 + hstepA, voffA);
            PG8_WAIT_V(8); PG8_WAIT_L(0); PG8_BAR; PG8_MMA(0, 0, At, B0); PG8_MMA(0, 1, At, B1); PG8_BAR; PG8_SCHED;
            if constexpr (!HALF_M) PG8_LDA(At, 1, 1); PG8_STAGE(PG8_SB(1, 0), b3, voffB); PG8_STAGE(PG8_SB(1, 1), b3 + hstepB, voffB); PG8_STAGE(PG8_SA(1, 0), a3, voffA);
            PG8_WAIT_V(8); PG8_WAIT_L(0); PG8_BAR; if constexpr (!HALF_M) { PG8_MMA(1, 0, At, B0); PG8_MMA(1, 1, At, B1); } PG8_BAR; PG8_SCHED;
            } else {
            PG8_LDB(B0, 0, 0); PG8_SCHED; PG8_LDA(At, 0, 0); PG8_STAGE(PG8_SA(1, 1), a1 + hstepA, voffA);
            PG8_WAIT_L(8); PG8_BAR; PG8_WAIT_L(0); PG8_MMA(0, 0, At, B0); PG8_BAR; PG8_SCHED;
            PG8_LDB(B1, 0, 1); PG8_STAGE(PG8_SB(0, 0), b2, voffB);
            PG8_BAR; PG8_WAIT_L(0); PG8_MMA(0, 1, At, B1); PG8_BAR;
            PG8_LDA(At, 0, 1); PG8_STAGE(PG8_SA(0, 0), a2, voffA);
            PG8_BAR; PG8_WAIT_L(0); PG8_MMA(1, 0, At, B0); PG8_BAR; PG8_SCHED;
            PG8_STAGE(PG8_SB(0, 1), b2 + hstepB, voffB);
            PG8_WAIT_V(6); PG8_BAR; PG8_MMA(1, 1, At, B1); PG8_BAR;
            PG8_LDB(B0, 1, 0); PG8_SCHED; PG8_LDA(At, 1, 0); PG8_STAGE(PG8_SA(0, 1), a2 + hstepA, voffA);
            PG8_WAIT_L(8); PG8_BAR; PG8_WAIT_L(0); PG8_MMA(0, 0, At, B0); PG8_BAR; PG8_SCHED;
            PG8_LDB(B1, 1, 1); PG8_STAGE(PG8_SB(1, 0), b3, voffB);
            PG8_BAR; PG8_WAIT_L(0); PG8_MMA(0, 1, At, B1); PG8_BAR;
            PG8_LDA(At, 1, 1); PG8_STAGE(PG8_SA(1, 0), a3, voffA);
            PG8_BAR; PG8_WAIT_L(0); PG8_MMA(1, 0, At, B0); PG8_BAR; PG8_SCHED;
            PG8_STAGE(PG8_SB(1, 1), b3 + hstepB, voffB);
            PG8_WAIT_V(6); PG8_BAR; PG8_MMA(1, 1, At, B1); PG8_BAR;
            }
        }
        if constexpr (ALIGN_EPI) { if (wr == 0) PG8_BAR; }
        if constexpr (FP8) asm volatile("s_nop 15\n\ts_nop 15" ::: "memory");
        E(acc, cur, wr, wc, fr, fq);
        if (!has_next) break;
#pragma unroll
        for (int a = 0; a < 2; ++a)
#pragma unroll
            for (int b = 0; b < 2; ++b)
#pragma unroll
                for (int m = 0; m < 4; ++m)
#pragma unroll
                    for (int n = 0; n < 2; ++n) acc[a][b][m][n] = (f32x4){0.f, 0.f, 0.f, 0.f};
        cur = nxt; cA = nA; cB = nB; ++ui;
        if constexpr (ALIGN_EPI) { if (wr == 1) PG8_BAR; }
    }
    PG8_WAIT_V(0);
    if constexpr (!ALIGN_EPI) { if (wr == 0) PG8_BAR; }
    PG8_BAR;
#undef PG8_SA
#undef PG8_SB
#undef PG8_STAGE
#undef PG8_LDA
#undef PG8_LDB
#undef PG8_MMA
#undef PG8_WAIT_V
#undef PG8_WAIT_L
#undef PG8_BAR
#undef PG8_SCHED
}

template <bool HM = false> struct EpiProjT {
    static constexpr bool PERM = true;
    bf16_t* O; int ldc; const float* ss; int mode; float oscale;
    __device__ __forceinline__ int act_of(int pn) const {
        if (mode) return 0;
        if (pn < 4) return 1; if (pn < 6) return 2; if (pn < 8) return 0; if (pn < 10) return 2; if (pn < 16) return 4; if (pn < 20) return 0;
        if (pn < 22) return 2; if (pn < 24) return 4; if (pn < 26) return 2; return 3;
    }
    __device__ __forceinline__ void operator()(const f32x4 (&acc)[2][2][4][2], const Unit& u, int wr, int wc, int fr, int fq) const {
        const int row0 = u.pm * BM + (HM ? u.z * HALF_ROWS : 0) + wr * 64 + fr, col0 = u.pn * BM + wc * 32 + 8 * fq; const int act = act_of(u.pn);
        float ssv[2][4];
#pragma unroll
        for (int ai = 0; ai < (HM ? 1 : 2); ++ai)
#pragma unroll
            for (int m = 0; m < 4; ++m) ssv[ai][m] = ss[row0 + ai * HALF + m * 16];
        asm volatile("" ::: "memory");
#pragma unroll
        for (int ai = 0; ai < (HM ? 1 : 2); ++ai)
#pragma unroll
            for (int m = 0; m < 4; ++m) { const int row = row0 + ai * HALF + m * 16; const float rs = oscale / sqrtf(ssv[ai][m] * (1.0f / 1024.0f) + EPS);
                bf16_t* rowp = O + (size_t)row * ldc + col0;
#pragma unroll
                for (int bj = 0; bj < 2; ++bj) { f32x4 v0 = acc[ai][bj][m][0] * rs, v1 = acc[ai][bj][m][1] * rs;
                    if (act == 1) { for (int e = 0; e < 4; ++e) { v0[e] = geluf_(v0[e]); v1[e] = geluf_(v1[e]); } }
                    else if (act == 2) { for (int e = 0; e < 4; ++e) { v0[e] = siluf_(v0[e]); v1[e] = siluf_(v1[e]); } }
                    else if (act == 3) {
                        unsigned q[8];
                        for (int e = 0; e < 4; ++e) { q[e] = (unsigned)(sigmoidf_(v0[e]) * 255.0f + 0.5f); q[4 + e] = (unsigned)(sigmoidf_(v1[e]) * 255.0f + 0.5f); }
                        u32x2 w8; w8.x = q[0] | (q[1] << 8) | (q[2] << 16) | (q[3] << 24); w8.y = q[4] | (q[5] << 8) | (q[6] << 16) | (q[7] << 24);
                        *(u32x2*)((unsigned char*)(O + (size_t)row * ldc + C_GM) + (col0 + bj * HALF - C_GM)) = w8; continue; }
                    else if (act == 4) { v0 = v0 * QSCALE; v1 = v1 * QSCALE; }
                    u32x4 w; w.x = cvt_pk_bf16(v0[0], v0[1]); w.y = cvt_pk_bf16(v0[2], v0[3]); w.z = cvt_pk_bf16(v1[0], v1[1]); w.w = cvt_pk_bf16(v1[2], v1[3]);
                    *(u32x4*)(rowp + bj * HALF) = w; } }
    }
};
typedef EpiProjT<false> EpiProj;
struct EpiMerge {
    static constexpr bool PERM = true;
    const bf16_t* gates; int ldg; bf16_t* Z;
    __device__ __forceinline__ void operator()(const f32x4 (&acc)[2][2][4][2], const Unit& u, int wr, int wc, int fr, int fq) const {
        const int row0 = u.pm * BM + wr * 64 + fr, col0 = u.pn * BM + wc * 32 + 8 * fq; const int z = u.z;
        const unsigned char* gbase = (const unsigned char*)(gates + (size_t)row0 * ldg) + z * DM + col0; bf16_t* zbase = Z + (size_t)row0 * DM + col0;
        u32x2 gw[8][2]; u32x4 pz[8][2];
#define EM_LOAD(s) do { const int r_ = ((s) >> 2) * HALF + ((s) & 3) * 16; _Pragma("unroll") for (int bj = 0; bj < 2; ++bj) { gw[s][bj] = *(const u32x2*)(gbase + (size_t)r_ * ldg * 2 + bj * HALF); \
            if (z > 0) pz[s][bj] = *(const u32x4*)(zbase + (size_t)r_ * DM + bj * HALF); else pz[s][bj] = (u32x4){0u, 0u, 0u, 0u}; } } while (0)
        EM_LOAD(0); EM_LOAD(1); EM_LOAD(2); asm volatile("" ::: "memory");
#pragma unroll
        for (int s = 0; s < 8; ++s) {
            if (s + 3 < 8) { EM_LOAD(s + 3); }
            asm volatile("" ::: "memory");
            const int ai = s >> 2, m = s & 3, r_ = ai * HALF + m * 16;
#pragma unroll
            for (int bj = 0; bj < 2; ++bj) { const u32x2 g = gw[s][bj]; const u32x4 q = pz[s][bj]; const float k255 = 1.0f / 255.0f;
                f32x4 v0 = acc[ai][bj][m][0] * k255, v1 = acc[ai][bj][m][1] * k255;
                v0[0] = v0[0] * (float)((g.x >> 0) & 0xffu) + bflo(q.x); v0[1] = v0[1] * (float)((g.x >> 8) & 0xffu) + bfhi(q.x); v0[2] = v0[2] * (float)((g.x >> 16) & 0xffu) + bflo(q.y); v0[3] = v0[3] * (float)((g.x >> 24) & 0xffu) + bfhi(q.y);
                v1[0] = v1[0] * (float)((g.y >> 0) & 0xffu) + bflo(q.z); v1[1] = v1[1] * (float)((g.y >> 8) & 0xffu) + bfhi(q.z); v1[2] = v1[2] * (float)((g.y >> 16) & 0xffu) + bflo(q.w); v1[3] = v1[3] * (float)((g.y >> 24) & 0xffu) + bfhi(q.w);
                u32x4 w; w.x = cvt_pk_bf16(v0[0], v0[1]); w.y = cvt_pk_bf16(v0[2], v0[3]); w.z = cvt_pk_bf16(v1[0], v1[1]); w.w = cvt_pk_bf16(v1[2], v1[3]);
                *(u32x4*)(zbase + (size_t)r_ * DM + bj * HALF) = w; }
            asm volatile("" ::: "memory");
        }
#undef EM_LOAD
    }
};
struct EpiOut {
    static constexpr bool PERM = true;
    const float* xi; float* xo; bf16_t* xb; float* ssn; unsigned char* xb8; int wr_xb;
    __device__ __forceinline__ void operator()(const f32x4 (&acc)[2][2][4][2], const Unit& u, int wr, int wc, int fr, int fq) const {
        const int row0 = u.pm * BM + wr * 64 + fr, col0 = u.pn * BM + wc * 32 + 8 * fq;
        const size_t base = (size_t)row0 * DM + col0;
        f32x4 xv[8][2][2];
#define EO_LOAD(s) do { const size_t o_ = base + (size_t)(((s) >> 2) * HALF + ((s) & 3) * 16) * DM; _Pragma("unroll") for (int bj = 0; bj < 2; ++bj) { \
            xv[s][bj][0] = *(const f32x4*)(xi + o_ + bj * HALF); xv[s][bj][1] = *(const f32x4*)(xi + o_ + bj * HALF + 4); } } while (0)
        EO_LOAD(0); EO_LOAD(1); EO_LOAD(2); asm volatile("" ::: "memory");
#pragma unroll
        for (int s = 0; s < 8; ++s) {
            if (s + 3 < 8) { EO_LOAD(s + 3); }
            asm volatile("" ::: "memory");
            const int ai = s >> 2, m = s & 3; const size_t o_ = base + (size_t)(ai * HALF + m * 16) * DM; float sq = 0.f;
#pragma unroll
            for (int bj = 0; bj < 2; ++bj) { const f32x4 v0 = xv[s][bj][0] + acc[ai][bj][m][0], v1 = xv[s][bj][1] + acc[ai][bj][m][1];
                *(f32x4*)(xo + o_ + bj * HALF) = v0; *(f32x4*)(xo + o_ + bj * HALF + 4) = v1;
                u32x4 w; w.x = cvt_pk_bf16(v0[0], v0[1]); w.y = cvt_pk_bf16(v0[2], v0[3]); w.z = cvt_pk_bf16(v1[0], v1[1]); w.w = cvt_pk_bf16(v1[2], v1[3]);
                if (wr_xb) { *(u32x4*)(xb + o_ + bj * HALF) = w;
                  u32x2 w8; int t8 = 0; t8 = __builtin_amdgcn_cvt_pk_fp8_f32(v0[0], v0[1], t8, false); t8 = __builtin_amdgcn_cvt_pk_fp8_f32(v0[2], v0[3], t8, true); w8.x = (unsigned)t8;
                  t8 = 0; t8 = __builtin_amdgcn_cvt_pk_fp8_f32(v1[0], v1[1], t8, false); t8 = __builtin_amdgcn_cvt_pk_fp8_f32(v1[2], v1[3], t8, true); w8.y = (unsigned)t8; *(u32x2*)(xb8 + o_ + bj * HALF) = w8; }
                sq += (v0[0] * v0[0] + v0[1] * v0[1]) + (v0[2] * v0[2] + v0[3] * v0[3]) + (v1[0] * v1[0] + v1[1] * v1[1]) + (v1[2] * v1[2] + v1[3] * v1[3]); }
            sq += __shfl_xor(sq, 16); sq += __shfl_xor(sq, 32);
            if (fq == 0) atomicAdd(ssn + row0 + ai * HALF + m * 16, sq);
            asm volatile("" ::: "memory");
        }
#undef EO_LOAD
    }
};
}
struct Params {
    const float *x, *mem, *norm_g, *w_in, *gm_ln_g, *gm_ln_b, *gm_ws, *gm_bs, *pool_w, *pool_scale, *mem_norm_g, *w_mem_kv, *w_branch, *w_out, *final_norm_g;
    float* out; unsigned char* ws;
};
constexpr int NWAVES = 8, NTHREADS = 512;
#define LDS_WAIT() asm volatile("s_waitcnt lgkmcnt(0)" ::: "memory")

__device__ __forceinline__ float wave_sum(float v) {
#pragma unroll
    for (int o = 1; o < 64; o <<= 1) v += __shfl_xor(v, o);
    return v;
}
__device__ __forceinline__ s16x4 vtr(const LAS unsigned char* p) { return __builtin_bit_cast(s16x4, __builtin_amdgcn_ds_read_tr16_b64_v4i16((LAS s16x4*)p)); }
__device__ __forceinline__ bf16x8 cat8(s16x4 a, s16x4 b) { return __builtin_shufflevector(a, b, 0, 1, 2, 3, 4, 5, 6, 7); }

template <bool F8 = false> __device__ __forceinline__ void p0_transpose_item(const float* W, int K, int N, bf16_t* WT, const float* ks, LAS float* scr, int item, int lane, unsigned char* WT8 = nullptr, int n8 = 0, float s8 = 1.f) {
    const int nblk = N / 64, kb = item / nblk, nb = item % nblk, k0 = 64 * kb, n0 = 64 * nb;
    const int lr = lane >> 4, lc = (lane & 15) * 4;
    f32x4 v[16];
#pragma unroll
    for (int i = 0; i < 16; ++i) v[i] = *(const f32x4*)(W + (size_t)(k0 + 4 * i + lr) * N + n0 + lc);
#pragma unroll
    for (int i = 0; i < 16; ++i) { const int k = 4 * i + lr; const float sc = ks ? ks[k0 + k] : 1.0f;
        *(LAS f32x4*)(scr + k * 64 + (lc ^ (4 * ((k >> 3) & 7)))) = v[i] * sc; }
    LDS_WAIT(); asm volatile("" ::: "memory");
    const int c = lane & 7;
#pragma unroll
    for (int j = 0; j < 8; ++j) { const int n = (lane >> 3) + 8 * j; const LAS float* s = scr + (8 * c) * 64 + (n ^ (4 * c));
        u32x4 o; o.x = cvt_pk_bf16(s[0 * 64], s[1 * 64]); o.y = cvt_pk_bf16(s[2 * 64], s[3 * 64]); o.z = cvt_pk_bf16(s[4 * 64], s[5 * 64]); o.w = cvt_pk_bf16(s[6 * 64], s[7 * 64]);
        if (F8 && is_fp8_tile(n0 >> 8)) { u32x2 o8; int t8 = 0; t8 = __builtin_amdgcn_cvt_pk_fp8_f32(s[0 * 64] * s8, s[1 * 64] * s8, t8, false); t8 = __builtin_amdgcn_cvt_pk_fp8_f32(s[2 * 64] * s8, s[3 * 64] * s8, t8, true); o8.x = (unsigned)t8;
            t8 = 0; t8 = __builtin_amdgcn_cvt_pk_fp8_f32(s[4 * 64] * s8, s[5 * 64] * s8, t8, false); t8 = __builtin_amdgcn_cvt_pk_fp8_f32(s[6 * 64] * s8, s[7 * 64] * s8, t8, true); o8.y = (unsigned)t8;
            *(u32x2*)(WT8 + (size_t)(n0 + n) * K + k0 + 8 * c) = o8; }
        else *(u32x4*)(WT + (size_t)(n0 + n) * K + k0 + 8 * c) = o; }
    LDS_WAIT(); asm volatile("" ::: "memory");
}
__device__ __forceinline__ void row_to_bf16(const float* xrow, bf16_t* orow, float* ssp, int lane, unsigned char* o8row = nullptr) {
    const f32x4* xr = (const f32x4*)xrow + lane;
    f32x4 v[4]; float s = 0.f;
#pragma unroll
    for (int j = 0; j < 4; ++j) { v[j] = xr[64 * j]; s += (v[j].x * v[j].x + v[j].y * v[j].y) + (v[j].z * v[j].z + v[j].w * v[j].w); }
    s = wave_sum(s);
    u32x2* o8 = (u32x2*)orow + lane;
#pragma unroll
    for (int j = 0; j < 4; ++j) { u32x2 w; w.x = cvt_pk_bf16(v[j].x, v[j].y); w.y = cvt_pk_bf16(v[j].z, v[j].w); o8[64 * j] = w; }
    if (o8row) { unsigned* o4 = (unsigned*)o8row + lane;
#pragma unroll
        for (int j = 0; j < 4; ++j) { int t8 = 0; t8 = __builtin_amdgcn_cvt_pk_fp8_f32(v[j].x, v[j].y, t8, false); t8 = __builtin_amdgcn_cvt_pk_fp8_f32(v[j].z, v[j].w, t8, true); o4[64 * j] = (unsigned)t8; } }
    if (lane == 0) *ssp = s;
}

__device__ __forceinline__ void prologue(const Params& p, LAS unsigned char* lds, int vcu, int G, int wave, int lane) {
    unsigned char* ws = p.ws;
    LAS float* scr = (LAS float*)(lds + wave * 16384);
    const int gw = vcu * NWAVES + wave, NGW = G * NWAVES;
    constexpr int I_IN = (DM / 64) * (DIN / 64);
    constexpr int I_BR = (BW / 64) * (DM / 64);
    constexpr int I_SQ = (DM / 64) * (DM / 64);
    constexpr int I_PW = (128 / 64) * (128 / 64);
    constexpr int N_IN = DEPTH * I_IN, N_BR = DEPTH * 4 * I_BR, N_SQ = DEPTH * I_SQ, N_PW = DEPTH * 4 * I_PW;
    constexpr int NITEMS = N_IN + N_BR + 2 * N_SQ + N_PW;
    for (int it = gw; it < NITEMS; it += NGW) {
        int r = it;
        if (r < N_IN) { const int l = r / I_IN; p0_transpose_item<true>(p.w_in + (size_t)l * DM * DIN, DM, DIN, (bf16_t*)(ws + WS_WIN) + (size_t)l * DIN * DM, p.norm_g + l * DM, scr, r % I_IN, lane, ws + WS_WG8 + (size_t)l * DIN * DM, 0, WG8_SCALE); continue; } r -= N_IN;
        if (r < N_BR) { const int lb = r / I_BR; p0_transpose_item(p.w_branch + (size_t)lb * BW * DM, BW, DM, (bf16_t*)(ws + WS_WBR) + (size_t)lb * DM * BW, nullptr, scr, r % I_BR, lane); continue; } r -= N_BR;
        if (r < N_SQ) { const int l = r / I_SQ; p0_transpose_item(p.w_out + (size_t)l * DM * DM, DM, DM, (bf16_t*)(ws + WS_WOUT) + (size_t)l * DM * DM, nullptr, scr, r % I_SQ, lane); continue; } r -= N_SQ;
        if (r < N_SQ) { const int l = r / I_SQ; p0_transpose_item(p.w_mem_kv + (size_t)l * DM * DM, DM, DM, (bf16_t*)(ws + WS_WKV) + (size_t)l * DM * DM, p.mem_norm_g + l * DM, scr, r % I_SQ, lane); continue; } r -= N_SQ;
        { const int lg = r / I_PW; p0_transpose_item(p.pool_w + (size_t)lg * 128 * 128, 128, 128, (bf16_t*)(ws + WS_POOLW) + (size_t)lg * 128 * 128, nullptr, scr, r % I_PW, lane); }
    }
    { const int gt = gw * 64 + lane, NGT = NGW * 64; bf16_t* o = (bf16_t*)(ws + WS_GMWS);
      for (int i = gt; i < DEPTH * 4 * 128 * 128 / 2; i += NGT) { const int e = 2 * i, s = e & 127, t = (e >> 7) & 127; const f32x2 v = *(const f32x2*)(p.gm_ws + e);
          ((unsigned*)o)[i] = cvt_pk_bf16(s <= t ? v.x : 0.f, (s + 1) <= t ? v.y : 0.f); }
      float* ss = (float*)(ws + WS_ROWSS);
      for (int i = gt; i < 4 * NTOK; i += NGT) ss[NTOK + i] = 0.f; }
    for (int m = gw; m < NTOK; m += 2 * NGW) {
        const int m1 = (m + NGW < NTOK) ? m + NGW : m;
        const f32x4* xa = (const f32x4*)(p.x + (size_t)m * DM) + lane; const f32x4* xb_ = (const f32x4*)(p.x + (size_t)m1 * DM) + lane;
        f32x4 va[4], vb[4]; float sa = 0.f, sb = 0.f;
#pragma unroll
        for (int j = 0; j < 4; ++j) { va[j] = xa[64 * j]; vb[j] = xb_[64 * j]; }
#pragma unroll
        for (int j = 0; j < 4; ++j) { sa += (va[j].x * va[j].x + va[j].y * va[j].y) + (va[j].z * va[j].z + va[j].w * va[j].w); sb += (vb[j].x * vb[j].x + vb[j].y * vb[j].y) + (vb[j].z * vb[j].z + vb[j].w * vb[j].w); }
#pragma unroll
        for (int o = 1; o < 64; o <<= 1) { sa += __shfl_xor(sa, o); sb += __shfl_xor(sb, o); }
        u32x2* oa = (u32x2*)((bf16_t*)(ws + WS_XB) + (size_t)m * DM) + lane; u32x2* ob = (u32x2*)((bf16_t*)(ws + WS_XB) + (size_t)m1 * DM) + lane;
        unsigned* qa = (unsigned*)(ws + WS_XB8 + (size_t)m * DM) + lane; unsigned* qb = (unsigned*)(ws + WS_XB8 + (size_t)m1 * DM) + lane;
#pragma unroll
        for (int j = 0; j < 4; ++j) { u32x2 w; w.x = cvt_pk_bf16(va[j].x, va[j].y); w.y = cvt_pk_bf16(va[j].z, va[j].w); oa[64 * j] = w; w.x = cvt_pk_bf16(vb[j].x, vb[j].y); w.y = cvt_pk_bf16(vb[j].z, vb[j].w); ob[64 * j] = w;
            int t8 = 0; t8 = __builtin_amdgcn_cvt_pk_fp8_f32(va[j].x, va[j].y, t8, false); t8 = __builtin_amdgcn_cvt_pk_fp8_f32(va[j].z, va[j].w, t8, true); qa[64 * j] = (unsigned)t8;
            t8 = 0; t8 = __builtin_amdgcn_cvt_pk_fp8_f32(vb[j].x, vb[j].y, t8, false); t8 = __builtin_amdgcn_cvt_pk_fp8_f32(vb[j].z, vb[j].w, t8, true); qb[64 * j] = (unsigned)t8; }
        if (lane == 0) { ((float*)(ws + WS_ROWSS))[m] = sa; ((float*)(ws + WS_ROWSS))[m1] = sb; }
    }
    for (int m = gw; m < NB * MEMLEN; m += NGW) row_to_bf16(p.mem + (size_t)m * DM, (bf16_t*)(ws + WS_MEMB) + (size_t)m * DM, (float*)(ws + WS_MEMSS) + m, lane);
}

constexpr int KP = 272, VP = 288;
constexpr int ATT_V_OFF = 256 * KP;
struct AttnCtx { int h, n, dil, tq0, tk0; const bf16_t *Kb, *Vb, *Qb; size_t kvp; };
template <int kind> __device__ __forceinline__ AttnCtx attn_decode(const Params& p, int l, int idx) {
    bf16_t* proj = (bf16_t*)(p.ws + WS_PROJ);
    AttnCtx c; c.h = idx & 3; const int rest = idx >> 2; c.dil = 1; c.n = 0;
    if (kind < 3) {
        c.dil = (kind == 0) ? 1 : (kind == 1 ? 4 : 16); const int nb = 32 / c.dil;
        c.n = rest % nb; const int r = (rest / nb) % c.dil, b = rest / (nb * c.dil);
        c.tq0 = b * SEQ + (c.n * 128) * c.dil + r;
        c.tk0 = b * SEQ + ((c.n - 1) * 128) * c.dil + r;
        c.Kb = proj + C_CK + c.h * 128; c.Vb = proj + C_CV + c.h * 128; c.kvp = DIN; c.Qb = proj + C_CQ + kind * BW + c.h * 128;
    } else {
        const int b = rest >> 5; c.tq0 = rest * 128; c.tk0 = b * MEMLEN;
        const bf16_t* kv = (const bf16_t*)(p.ws + WS_MEMKV) + l * DM + c.h * 128; c.Kb = kv; c.Vb = kv + BW; c.kvp = DEPTH * DM; c.Qb = proj + C_MQ + c.h * 128;
    }
    return c;
}
template <int kind> __device__ __forceinline__ void attn_issue(const Params& p, int l, int idx, int tid, int wave, int lane, u32x4 (&kreg)[8], u32x4 (&vreg)[8], bf16x8 (&qf)[4]) {
    const AttnCtx c = attn_decode<kind>(p, l, idx);
    const int ch = tid & 15, r0 = tid >> 4, fr = lane & 15, fq = lane >> 4;
#pragma unroll
    for (int i = 0; i < 8; ++i) { const int j = r0 + 32 * i; int tok = c.tk0 + j * c.dil; if (kind < 3 && c.n == 0 && j < 128) tok = c.tq0;
        kreg[i] = *(const u32x4*)(c.Kb + (size_t)tok * c.kvp + ch * 8); vreg[i] = *(const u32x4*)(c.Vb + (size_t)tok * c.kvp + ch * 8); }
    const size_t qtok = (size_t)(c.tq0 + (16 * wave + fr) * c.dil);
#pragma unroll
    for (int ks = 0; ks < 4; ++ks) qf[ks] = *(const bf16x8*)(c.Qb + qtok * DIN + 32 * ks + 8 * fq);
    asm volatile("" ::: "memory");
}
__device__ __forceinline__ void attn_stage(LAS unsigned char* lds, int tid, const u32x4 (&kreg)[8], const u32x4 (&vreg)[8]) {
    const int ch = tid & 15, r0 = tid >> 4;
#pragma unroll
    for (int i = 0; i < 8; ++i) { const int j = r0 + 32 * i;
        *(LAS u32x4*)(lds + j * KP + ch * 16) = kreg[i]; *(LAS u32x4*)(lds + ATT_V_OFF + j * VP + ch * 16) = vreg[i]; }
    __syncthreads();
}
template <int kind> __device__ __forceinline__ void attn_compute(const Params& p, int l, int idx, LAS unsigned char* lds, int wave, int lane, const bf16x8 (&qf)[4]) {
    bf16_t* proj = (bf16_t*)(p.ws + WS_PROJ);
    const AttnCtx c = attn_decode<kind>(p, l, idx);
    const int h = c.h, n = c.n, dil = c.dil;
    const int fr = lane & 15, fq = lane >> 4;
    const int qi = 16 * wave + fr; const size_t qtok = (size_t)(c.tq0 + qi * dil);
    u32x2 mg[8];
    if (kind == 3) { const bf16_t* gp0 = proj + qtok * DIN + C_MG + h * 128 + 4 * fq;
#pragma unroll
        for (int dt = 0; dt < 8; ++dt) mg[dt] = *(const u32x2*)(gp0 + 16 * dt); }
    const int tlo = (kind < 3) ? wave : 0, thi = (kind < 3) ? wave + 8 : 15;
    f32x4 s[16];
#pragma unroll
    for (int t = 0; t < 16; ++t) s[t] = (f32x4){0.f, 0.f, 0.f, 0.f};
#pragma unroll
    for (int t2 = 0; t2 < 16; t2 += 2) {
        if (t2 + 1 >= tlo && t2 <= thi) {
            bf16x8 kf[2][4];
#pragma unroll
            for (int u = 0; u < 2; ++u)
#pragma unroll
                for (int ks = 0; ks < 4; ++ks) kf[u][ks] = *(const LAS bf16x8*)(lds + (16 * (t2 + u) + fr) * KP + (32 * ks + 8 * fq) * 2);
            __builtin_amdgcn_sched_barrier(0);
#pragma unroll
            for (int u = 0; u < 2; ++u)
#pragma unroll
                for (int ks = 0; ks < 4; ++ks) s[t2 + u] = __builtin_amdgcn_mfma_f32_16x16x32_bf16(kf[u][ks], qf[ks], s[t2 + u], 0, 0, 0);
            __builtin_amdgcn_sched_barrier(0);
        } }
    if (kind < 3) {
        const int jlo = (n == 0) ? (qi > 128 ? qi : 128) : qi, jhi = qi + 128;
#pragma unroll
        for (int t = 0; t < 16; ++t)
#pragma unroll
            for (int e = 0; e < 4; ++e) { const int j = 16 * t + 4 * fq + e; if (j < jlo || j > jhi) s[t][e] = -1e30f; }
    }
    float mx = -3e38f;
#pragma unroll
    for (int t = 0; t < 16; ++t) mx = fmaxf(fmaxf(fmaxf(s[t][0], s[t][1]), fmaxf(s[t][2], s[t][3])), mx);
    mx = fmaxf(mx, __shfl_xor(mx, 16)); mx = fmaxf(mx, __shfl_xor(mx, 32));
    float sum = 0.f;
#pragma unroll
    for (int t = 0; t < 16; ++t)
#pragma unroll
        for (int e = 0; e < 4; ++e) { const float pe = fast_exp2(s[t][e] - mx); s[t][e] = pe; sum += pe; }
    sum += __shfl_xor(sum, 16); sum += __shfl_xor(sum, 32);
    f32x4 o[8];
#pragma unroll
    for (int dt = 0; dt < 8; ++dt) o[dt] = (f32x4){0.f, 0.f, 0.f, 0.f};
    const LAS unsigned char* vbase = lds + ATT_V_OFF + (4 * fq + (fr >> 2)) * VP + (fr & 3) * 8;
#pragma unroll
    for (int j = 0; j < 8; ++j) {
        u32x4 pw; pw.x = cvt_pk_bf16(s[2 * j][0], s[2 * j][1]); pw.y = cvt_pk_bf16(s[2 * j][2], s[2 * j][3]); pw.z = cvt_pk_bf16(s[2 * j + 1][0], s[2 * j + 1][1]); pw.w = cvt_pk_bf16(s[2 * j + 1][2], s[2 * j + 1][3]);
        const bf16x8 pf = __builtin_bit_cast(bf16x8, pw);
        if (2 * j + 1 >= tlo && 2 * j <= thi) {
            bf16x8 vf[8];
#pragma unroll
            for (int dt = 0; dt < 8; ++dt) { const s16x4 v0 = vtr(vbase + (32 * j) * VP + dt * 32), v1 = vtr(vbase + (32 * j + 16) * VP + dt * 32); vf[dt] = cat8(v0, v1); }
            __builtin_amdgcn_sched_barrier(0);
#pragma unroll
            for (int dt = 0; dt < 8; ++dt) o[dt] = __builtin_amdgcn_mfma_f32_16x16x32_bf16(vf[dt], pf, o[dt], 0, 0, 0);
            __builtin_amdgcn_sched_barrier(0);
        }
    }
    const float inv = fast_rcp(sum);
    if (kind < 3) {
        bf16_t* og = (bf16_t*)(p.ws + WS_OG) + ((size_t)kind * NTOK + qtok) * BW + h * 128 + 4 * fq;
#pragma unroll
        for (int dt = 0; dt < 8; ++dt) { u32x2 w; w.x = cvt_pk_bf16(o[dt][0] * inv, o[dt][1] * inv); w.y = cvt_pk_bf16(o[dt][2] * inv, o[dt][3] * inv); *(u32x2*)(og + 16 * dt) = w; }
        if (fq == 0) ((float*)(p.ws + WS_LSE))[((size_t)kind * 512 + idx) * 128 + qi] = mx + __builtin_amdgcn_logf(sum);
    } else {
        bf16_t* gp = proj + qtok * DIN + C_MG + h * 128 + 4 * fq;
#pragma unroll
        for (int dt = 0; dt < 8; ++dt) { const u32x2 g = mg[dt]; u32x2 w;
            w.x = cvt_pk_bf16(o[dt][0] * inv * bflo(g.x), o[dt][1] * inv * bfhi(g.x)); w.y = cvt_pk_bf16(o[dt][2] * inv * bflo(g.y), o[dt][3] * inv * bfhi(g.y)); *(u32x2*)(gp + 16 * dt) = w; }
    }
    __syncthreads();
}

template <int kind> __device__ __forceinline__ void attn_item(const Params& p, int l, int idx, LAS unsigned char* lds, int tid, int wave, int lane) {
    u32x4 kreg[8], vreg[8]; bf16x8 qf[4];
    attn_issue<kind>(p, l, idx, tid, wave, lane, kreg, vreg, qf);
    attn_stage(lds, tid, kreg, vreg);
    attn_compute<kind>(p, l, idx, lds, wave, lane, qf);
}

__device__ __forceinline__ void gmlp_item(const Params& p, int l, int idx, LAS unsigned char* lds, int tid, int wave, int lane) {
    bf16_t* proj = (bf16_t*)(p.ws + WS_PROJ);
    const int h = idx & 3, c = idx >> 2, t0 = c * 128;
    const int fr = lane & 15, fq = lane >> 4;
    {
        const int lg = lane >> 4, lc = lane & 15;
        const bf16_t* vbase = proj + (size_t)(t0 + 16 * wave + lg) * DIN + C_AV + lc * 8;
        u32x4 wv[4][4];
#pragma unroll
        for (int tg = 0; tg < 4; ++tg)
#pragma unroll
            for (int q = 0; q < 4; ++q) wv[tg][q] = *(const u32x4*)(vbase + (size_t)(4 * tg) * DIN + q * 128);
        const float* lgp = p.gm_ln_g + l * BW + h * 128 + lc * 8; const float* lbp = p.gm_ln_b + l * BW + h * 128 + lc * 8;
        const f32x4 g0 = *(const f32x4*)lgp, g1 = *(const f32x4*)(lgp + 4), b0 = *(const f32x4*)lbp, b1 = *(const f32x4*)(lbp + 4);
#pragma unroll
        for (int tg = 0; tg < 4; ++tg) {
            float s1 = 0.f, s2 = 0.f;
#pragma unroll
            for (int q = 0; q < 4; ++q) { const u32x4 w = wv[tg][q];
                const float a0 = bflo(w.x), a1 = bfhi(w.x), a2 = bflo(w.y), a3 = bfhi(w.y), a4 = bflo(w.z), a5 = bfhi(w.z), a6 = bflo(w.w), a7 = bfhi(w.w);
                s1 += ((a0 + a1) + (a2 + a3)) + ((a4 + a5) + (a6 + a7)); s2 += ((a0 * a0 + a1 * a1) + (a2 * a2 + a3 * a3)) + ((a4 * a4 + a5 * a5) + (a6 * a6 + a7 * a7)); }
#pragma unroll
            for (int o = 1; o < 16; o <<= 1) { s1 += __shfl_xor(s1, o); s2 += __shfl_xor(s2, o); }
            const float mean = s1 * (1.0f / 512.0f), var = fmaxf(s2 * (1.0f / 512.0f) - mean * mean, 0.f), rstd = 1.0f / sqrtf(var + EPS);
            const u32x4 w = (h == 0) ? wv[tg][0] : (h == 1) ? wv[tg][1] : (h == 2) ? wv[tg][2] : wv[tg][3];
            u32x4 o; o.x = cvt_pk_bf16((bflo(w.x) - mean) * rstd * g0[0] + b0[0], (bfhi(w.x) - mean) * rstd * g0[1] + b0[1]);
            o.y = cvt_pk_bf16((bflo(w.y) - mean) * rstd * g0[2] + b0[2], (bfhi(w.y) - mean) * rstd * g0[3] + b0[3]);
            o.z = cvt_pk_bf16((bflo(w.z) - mean) * rstd * g1[0] + b1[0], (bfhi(w.z) - mean) * rstd * g1[1] + b1[1]);
            o.w = cvt_pk_bf16((bflo(w.w) - mean) * rstd * g1[2] + b1[2], (bfhi(w.w) - mean) * rstd * g1[3] + b1[3]);
            *(LAS u32x4*)(lds + (16 * wave + 4 * tg + lg) * VP + lc * 16) = o; }
    }
    const int tt = 16 * wave + fr; const bf16_t* wsr = (const bf16_t*)(p.ws + WS_GMWS) + ((size_t)(l * 4 + h) * 128 + tt) * 128 + 8 * fq;
    const int jn = (wave >> 1) + 1;
    bf16x8 wf[4];
#pragma unroll
    for (int j = 0; j < 4; ++j) wf[j] = *(const bf16x8*)(wsr + 32 * j);
    bf16_t* up = proj + (size_t)(t0 + tt) * DIN + C_AU + h * 128 + 4 * fq; const bf16_t* gp = up + (C_AG - C_AU);
    u32x2 uu[8], gg[8];
#pragma unroll
    for (int et = 0; et < 8; ++et) { uu[et] = *(const u32x2*)(up + 16 * et); gg[et] = *(const u32x2*)(gp + 16 * et); }
    const float bs = p.gm_bs[(l * 4 + h) * 128 + tt];
    __syncthreads();
    f32x4 d[8];
#pragma unroll
    for (int et = 0; et < 8; ++et) d[et] = (f32x4){0.f, 0.f, 0.f, 0.f};
    const LAS unsigned char* vb = lds + (8 * fq + (fr >> 2)) * VP + (fr & 3) * 8;
#pragma unroll
    for (int j = 0; j < 4; ++j) { if (j < jn) {
        bf16x8 vf[8];
#pragma unroll
        for (int et = 0; et < 8; ++et) { const s16x4 v0 = vtr(vb + (32 * j) * VP + et * 32), v1 = vtr(vb + (32 * j + 4) * VP + et * 32); vf[et] = cat8(v0, v1); }
        __builtin_amdgcn_sched_barrier(0);
#pragma unroll
        for (int et = 0; et < 8; ++et) d[et] = __builtin_amdgcn_mfma_f32_16x16x32_bf16(vf[et], wf[j], d[et], 0, 0, 0);
        __builtin_amdgcn_sched_barrier(0); } }
#pragma unroll
    for (int et = 0; et < 8; ++et) { const u32x2 u = uu[et], g = gg[et]; u32x2 w;
        w.x = cvt_pk_bf16(bflo(u.x) * (d[et][0] + bs) * bflo(g.x), bfhi(u.x) * (d[et][1] + bs) * bfhi(g.x));
        w.y = cvt_pk_bf16(bflo(u.y) * (d[et][2] + bs) * bflo(g.y), bfhi(u.y) * (d[et][3] + bs) * bfhi(g.y)); *(u32x2*)(up + 16 * et) = w; }
    __syncthreads();
}

constexpr int POOL_D_OFF = 40960;
__device__ __forceinline__ void pool_item(const Params& p, int l, int idx, LAS unsigned char* lds, int tid, int wave, int lane) {
    bf16_t* proj = (bf16_t*)(p.ws + WS_PROJ);
    const int g = idx & 3, c = idx >> 2, t0 = c * 128, win = 2 << g, pos0 = t0 & (SEQ - 1);
    const int fr = lane & 15, fq = lane >> 4;
    const bf16_t* wt = (const bf16_t*)(p.ws + WS_POOLW) + (size_t)(l * 4 + g) * 128 * 128 + fr * 128 + 8 * fq;
    bf16x8 wfr[8][4];
#pragma unroll
    for (int ot = 0; ot < 8; ++ot)
#pragma unroll
        for (int j = 0; j < 4; ++j) wfr[ot][j] = *(const bf16x8*)(wt + (size_t)(16 * ot) * 128 + 32 * j);
    {
        const bf16_t* pin = proj + C_PI + g * 128;
#pragma unroll
        for (int k = 0; k < 5; ++k) { const int cidx = tid + k * NTHREADS; if (cidx < 143 * 16) { const int rr = cidx >> 4, ch = cidx & 15;
            u32x4 w = (u32x4){0u, 0u, 0u, 0u}; if (pos0 - 15 + rr >= 0) w = *(const u32x4*)(pin + (size_t)(t0 - 15 + rr) * DIN + ch * 8);
            *(LAS u32x4*)(lds + rr * KP + ch * 16) = w; } }
    }
    __syncthreads();
    {
        const int t = tid >> 2, part = tid & 3, pos = pos0 + t; const int cnt = (pos + 1 < win) ? pos + 1 : win;
        float a[32];
#pragma unroll
        for (int i = 0; i < 32; ++i) a[i] = 0.f;
        const LAS unsigned char* rp = lds + (t + 15) * KP + part * 64;
        for (int jj = 0; jj < win; ++jj) {
#pragma unroll
            for (int i = 0; i < 4; ++i) { const u32x4 w = *(const LAS u32x4*)(rp - jj * KP + i * 16);
                a[i * 8 + 0] += bflo(w.x); a[i * 8 + 1] += bfhi(w.x); a[i * 8 + 2] += bflo(w.y); a[i * 8 + 3] += bfhi(w.y); a[i * 8 + 4] += bflo(w.z); a[i * 8 + 5] += bfhi(w.z); a[i * 8 + 6] += bflo(w.w); a[i * 8 + 7] += bfhi(w.w); } }
        const float ic = 1.0f / (float)cnt;
#pragma unroll
        for (int i = 0; i < 4; ++i) { const u32x4 w = *(const LAS u32x4*)(rp + i * 16); u32x4 o;
            o.x = cvt_pk_bf16(a[i * 8 + 0] * ic - bflo(w.x), a[i * 8 + 1] * ic - bfhi(w.x)); o.y = cvt_pk_bf16(a[i * 8 + 2] * ic - bflo(w.y), a[i * 8 + 3] * ic - bfhi(w.y));
            o.z = cvt_pk_bf16(a[i * 8 + 4] * ic - bflo(w.z), a[i * 8 + 5] * ic - bfhi(w.z)); o.w = cvt_pk_bf16(a[i * 8 + 6] * ic - bflo(w.w), a[i * 8 + 7] * ic - bfhi(w.w));
            *(LAS u32x4*)(lds + POOL_D_OFF + t * KP + (part * 32 + i * 8) * 2) = o; }
    }
    __syncthreads();
    const int tt = 16 * wave + fr;
    bf16x8 df[4];
#pragma unroll
    for (int j = 0; j < 4; ++j) df[j] = *(const LAS bf16x8*)(lds + POOL_D_OFF + tt * KP + (32 * j + 8 * fq) * 2);
    const float* sc = p.pool_scale + l * BW + g * 128 + 4 * fq;
    bf16_t* gp = proj + (size_t)(t0 + tt) * DIN + C_PG + g * 128 + 4 * fq;
    u32x2 gtv[8];
#pragma unroll
    for (int ot = 0; ot < 8; ++ot) gtv[ot] = *(const u32x2*)(gp + 16 * ot);
    asm volatile("" ::: "memory");
#pragma unroll
    for (int ot = 0; ot < 8; ++ot) {
        f32x4 d = (f32x4){0.f, 0.f, 0.f, 0.f};
#pragma unroll
        for (int j = 0; j < 4; ++j) d = __builtin_amdgcn_mfma_f32_16x16x32_bf16(wfr[ot][j], df[j], d, 0, 0, 0);
        const f32x4 s4 = *(const f32x4*)(sc + 16 * ot); const u32x2 gt = gtv[ot]; u32x2 w;
        w.x = cvt_pk_bf16(d[0] * s4[0] * bflo(gt.x), d[1] * s4[1] * bfhi(gt.x)); w.y = cvt_pk_bf16(d[2] * s4[2] * bflo(gt.y), d[3] * s4[3] * bfhi(gt.y));
        *(u32x2*)(gp + 16 * ot) = w;
    }
    __syncthreads();
}

__device__ __forceinline__ void combine_phase(const Params& p, int gtid, int ngt) {
    bf16_t* proj = (bf16_t*)(p.ws + WS_PROJ); const bf16_t* og = (const bf16_t*)(p.ws + WS_OG); const float* lse = (const float*)(p.ws + WS_LSE);
    for (int i0 = gtid; i0 < NTOK * 64; i0 += 8 * ngt) {
        float l0[8], l1[8], l2[8]; u32x4 o0[8], o1[8], o2[8], g[8];
#pragma unroll
        for (int k = 0; k < 8; ++k) { int i = i0 + k * ngt; if (i >= NTOK * 64) i = i0; const int t = i >> 6, ch = (i & 63) * 8, h = ch >> 7;
            const int b = t >> 12, pos = t & (SEQ - 1);
            l0[k] = lse[((size_t)(0 * 512) + ((b * 32 + (pos >> 7)) * 4 + h)) * 128 + (pos & 127)];
            l1[k] = lse[((size_t)(1 * 512) + (((b * 4 + (pos & 3)) * 8 + (pos >> 9)) * 4 + h)) * 128 + ((pos >> 2) & 127)];
            l2[k] = lse[((size_t)(2 * 512) + (((b * 16 + (pos & 15)) * 2 + (pos >> 11)) * 4 + h)) * 128 + ((pos >> 4) & 127)];
            o0[k] = *(const u32x4*)(og + (size_t)t * BW + ch); o1[k] = *(const u32x4*)(og + ((size_t)NTOK + t) * BW + ch); o2[k] = *(const u32x4*)(og + ((size_t)2 * NTOK + t) * BW + ch);
            g[k] = *(const u32x4*)(proj + (size_t)t * DIN + C_CG + ch); }
        asm volatile("" ::: "memory");
#pragma unroll
        for (int k = 0; k < 8; ++k) { const int i = i0 + k * ngt; if (i >= NTOK * 64) continue; const int t = i >> 6, ch = (i & 63) * 8;
            const float mx = fmaxf(l0[k], fmaxf(l1[k], l2[k])); float a0 = fast_exp2(l0[k] - mx), a1 = fast_exp2(l1[k] - mx), a2 = fast_exp2(l2[k] - mx); const float inv = fast_rcp(a0 + a1 + a2); a0 *= inv; a1 *= inv; a2 *= inv;
            u32x4 w;
#define CMB(f) w.f = cvt_pk_bf16((a0 * bflo(o0[k].f) + a1 * bflo(o1[k].f) + a2 * bflo(o2[k].f)) * bflo(g[k].f), (a0 * bfhi(o0[k].f) + a1 * bfhi(o1[k].f) + a2 * bfhi(o2[k].f)) * bfhi(g[k].f))
            CMB(x); CMB(y); CMB(z); CMB(w);
#undef CMB
            *(u32x4*)(proj + (size_t)t * DIN + C_CG + ch) = w; }
    }
}

#define RLX_AGENT __ATOMIC_RELAXED, __HIP_MEMORY_SCOPE_AGENT
#define XB_TMO      128
#define XB_XCNT(j)  (256  + 64 * (j))
#define XB_XSUB(j)  (1280 + 64 * (j))
#define XB_XGEN(j)  (2304 + 64 * (j))
#define XB_TOP      3328
#define XB_TOPGEN   3392
#define XCD_BAR_WORDS 3456
#define XB_SPIN_CAP (1u << 18)

__device__ __forceinline__ unsigned xb_ld(unsigned* p)              { return __hip_atomic_load(p, __ATOMIC_RELAXED, __HIP_MEMORY_SCOPE_AGENT); }
__device__ __forceinline__ unsigned xb_add(unsigned* p, unsigned v) { return __hip_atomic_fetch_add(p, v, __ATOMIC_RELAXED, __HIP_MEMORY_SCOPE_AGENT); }
__device__ __forceinline__ unsigned xb_xcc_id() { return (unsigned)__builtin_amdgcn_s_getreg((3 << 11) | 20) & 0xFu; }
#define XB_SPIN(cond, bar) do { unsigned _sp = 0; while (cond) { __builtin_amdgcn_s_sleep(1); \
    if ((++_sp & 255u) == 0u) { if (xb_ld(&(bar)[XB_TMO])) break; if (_sp > XB_SPIN_CAP) { atomicAdd(&(bar)[XB_TMO], 1u); break; } } } } while (0)

struct XcdBarrier {
    unsigned* bar; unsigned x;
    volatile LAS unsigned* st;
};

__device__ __forceinline__ XcdBarrier xcd_barrier_post(unsigned* bar, volatile LAS unsigned* st) {
    XcdBarrier b; b.bar = bar; b.x = xb_xcc_id(); b.st = st;
    if (threadIdx.x == 0) (void)xb_add(&bar[XB_XCNT(b.x)], 1u);
    return b;
}
__device__ __forceinline__ void xcd_barrier_complete(unsigned* bar, unsigned x, unsigned& nloc, unsigned& nx) {
    const unsigned G = gridDim.x * gridDim.y * gridDim.z;
    unsigned sum, cnt, mine, sp = 0u;
    for (;;) {
        sum = 0u; cnt = 0u; mine = 0u;
#pragma unroll
        for (unsigned j = 0; j < 16; ++j) { const unsigned c = xb_ld(&bar[XB_XCNT(j)]); sum += c; cnt += (c > 0u) ? 1u : 0u; mine = (j == x) ? c : mine; }
        if (sum == G) break;
        __builtin_amdgcn_s_sleep(1);
        if ((++sp & 255u) == 0u) { if (xb_ld(&bar[XB_TMO])) break; if (sp > XB_SPIN_CAP) { atomicAdd(&bar[XB_TMO], 1u); break; } }
    }
    nloc = mine > 0u ? mine : 1u; nx = cnt > 0u ? cnt : 1u;
}

__device__ __forceinline__ void xcd_barrier(const XcdBarrier& b) {
    asm volatile("s_waitcnt vmcnt(0)" ::: "memory");
    __syncthreads();
    if (threadIdx.x == 0) {
        unsigned* bar = b.bar;
        __builtin_amdgcn_s_waitcnt(0);
        unsigned nloc = b.st[0], nx = b.st[1];
        if (nloc == 0u) { xcd_barrier_complete(bar, b.x, nloc, nx); b.st[0] = nloc; b.st[1] = nx; }
        const unsigned old = xb_add(&bar[XB_XSUB(b.x)], 1u);
        const unsigned gen = old / nloc;
        if (old + 1u == (gen + 1u) * nloc) {
            __builtin_amdgcn_fence(__ATOMIC_RELEASE, "agent");
            asm volatile("s_waitcnt vmcnt(0)" ::: "memory");
            const unsigned og = xb_add(&bar[XB_TOP], 1u);
            const unsigned tg = og / nx;
            if (og + 1u == (tg + 1u) * nx) xb_add(&bar[XB_TOPGEN], 1u);
            else XB_SPIN(xb_ld(&bar[XB_TOPGEN]) == tg, bar);
            __builtin_amdgcn_fence(__ATOMIC_ACQUIRE, "agent");
            xb_add(&bar[XB_XGEN(b.x)], 1u);
            asm volatile("s_waitcnt vmcnt(0)" ::: "memory");
        } else {
            XB_SPIN(xb_ld(&bar[XB_XGEN(b.x)]) == gen, bar);
            __builtin_amdgcn_fence(__ATOMIC_ACQUIRE, "agent");
            asm volatile("s_waitcnt vmcnt(0)" ::: "memory");
        }
    }
    __syncthreads();
}

#ifndef IT_MASK
#define IT_MASK 15
#endif
#ifndef PH_MASK
#define PH_MASK 31
#endif
__global__ void __launch_bounds__(NTHREADS, 2) mega_fwd(Params p) {
    extern __shared__ __attribute__((aligned(16))) unsigned char lds_raw[];
    LAS unsigned char* lds = (LAS unsigned char*)lds_raw;
    cg::grid_group grid = cg::this_grid();
    const int tid = threadIdx.x, lane = tid & 63, wave = __builtin_amdgcn_readfirstlane(tid >> 6);
    const int G = gridDim.x, bx = blockIdx.x;
    const int vcu = (G % 8 == 0) ? (bx % 8) * (G / 8) + bx / 8 : bx;
    unsigned char* ws = p.ws;
    bf16_t* proj = (bf16_t*)(ws + WS_PROJ);
    volatile LAS unsigned* xst = (volatile LAS unsigned*)(lds + LDS_BYTES - 64);
    if (tid < 16) xst[tid] = 0u;
    __syncthreads();
    (void)xcd_barrier_post((unsigned*)(ws + WS_CTL), xst);
    grid.sync();

    prologue(p, lds, vcu, G, wave, lane);
    { XcdBarrier xb_; xb_.bar = (unsigned*)(p.ws + WS_CTL); xb_.x = xb_xcc_id(); xb_.st = (volatile LAS unsigned*)(lds + LDS_BYTES - 64); xcd_barrier(xb_); }

    for (int l = 0; l < DEPTH; ++l) {
#if PH_MASK & 1
        { int tidp = threadIdx.x; asm volatile("" : "+v"(tidp));
        if (l == 0) {
            pg8::Gemm g{(const bf16_t*)(ws + WS_MEMB), (const bf16_t*)(ws + WS_WKV), DM, DM, DM};
            pg8::StaticOrder S; S.init(NB * MEMLEN, DEPTH * DM, G, (bx + G / 2) % G);
            pg8::EpiProj E{(bf16_t*)(ws + WS_MEMKV), DEPTH * DM, (const float*)(ws + WS_MEMSS), 1, 1.0f};
            pg8::gemm_phase<pg8::EpiProj, pg8::StaticOrder, true, true>(lds, g, S, E, tidp);
        }
        {
            pg8::Gemm g{(const bf16_t*)(ws + WS_XB8), (const bf16_t*)(ws + WS_WG8 + (size_t)l * DIN * DM), DM / 2, DM / 2, DM / 2};
            const int ntile = (NTOK / 256) * NT_FP8, full = ntile / G, rag = ntile - full * G;
            const bool halves = (l > 0) && (G % 2 == 0) && rag > 0 && rag <= G / 2;
            pg8::GateOrder S; S.base.init(NTOK, NT_FP8 * 256, G, bx); S.rounds = halves ? full : full + 1;
            pg8::EpiProj E{proj, DIN, (const float*)(ws + WS_ROWSS) + (size_t)l * NTOK, 0, 1.0f / WG8_SCALE};
            pg8::gemm_phase<pg8::EpiProj, pg8::GateOrder, true, true, false, true>(lds, g, S, E, tidp);
            if (halves) {
                pg8::ProjHalfOrder H; H.base.init(NTOK, NT_FP8 * 256, G, bx % (G / 2)); H.round = full; H.half = bx / (G / 2); H.hbytes = (long)128 * (DM / 2) * 2;
                pg8::EpiProjT<true> EH{proj, DIN, (const float*)(ws + WS_ROWSS) + (size_t)l * NTOK, 0, 1.0f / WG8_SCALE};
                pg8::gemm_phase<pg8::EpiProjT<true>, pg8::ProjHalfOrder, true, true, true, true>(lds, g, H, EH, tidp);
            }
        }
        {
            pg8::Gemm g{(const bf16_t*)(ws + WS_XB), (const bf16_t*)(ws + WS_WIN) + (size_t)l * DIN * DM, DM, DM, DM};
            pg8::ProjOrder S; S.base.init(NTOK, NT_BF16 * 256, G, bx); S.rounds = 1 << 20;
            pg8::EpiProj E{proj, DIN, (const float*)(ws + WS_ROWSS) + (size_t)l * NTOK, 0, 1.0f};
            pg8::gemm_phase<pg8::EpiProj, pg8::ProjOrder, true, true>(lds, g, S, E, tidp);
        }
        }
#endif
        { XcdBarrier xb_; xb_.bar = (unsigned*)(p.ws + WS_CTL); xb_.x = xb_xcc_id(); xb_.st = (volatile LAS unsigned*)(lds + LDS_BYTES - 64); xcd_barrier(xb_); }
#if PH_MASK & 2
        if (G == 256) {
            const int x = bx & 7, m = (bx >> 3) & 31;
            for (int k = 0; k < 2; ++k) { int tidp = threadIdx.x; asm volatile("" : "+v"(tidp)); const int lanep = tidp & 63, wavep = __builtin_amdgcn_readfirstlane(tidp >> 6);
                gmlp_item(p, l, (((k * 8 + x) * 8 + (m >> 2)) << 2) | (m & 3), lds, tidp, wavep, lanep); }
            for (int k = 0; k < 2; ++k) { int tidp = threadIdx.x; asm volatile("" : "+v"(tidp)); const int lanep = tidp & 63, wavep = __builtin_amdgcn_readfirstlane(tidp >> 6);
                const int j = bx + 256 * k; pool_item(p, l, k ? ((j & ~3) | (3 - (j & 3))) : j, lds, tidp, wavep, lanep); }
            for (int r = 0; r < 8; ++r) { int tidp = threadIdx.x; asm volatile("" : "+v"(tidp)); const int lanep = tidp & 63, wavep = __builtin_amdgcn_readfirstlane(tidp >> 6);
                const int idx = ((32 * ((x >> 2) + 2 * (r & 1)) + m) << 2) | (x & 3);
                if (r < 2) attn_item<0>(p, l, idx, lds, tidp, wavep, lanep); else if (r < 4) attn_item<1>(p, l, idx, lds, tidp, wavep, lanep);
                else if (r < 6) attn_item<2>(p, l, idx, lds, tidp, wavep, lanep); else attn_item<3>(p, l, idx, lds, tidp, wavep, lanep); }
        } else
        for (int it = bx; it < 3072; it += G) {
            int tidp = threadIdx.x; asm volatile("" : "+v"(tidp)); const int lanep = tidp & 63, wavep = __builtin_amdgcn_readfirstlane(tidp >> 6);
            const int cls = it >> 9, idx = it & 511;
            if (cls == 0) gmlp_item(p, l, idx, lds, tidp, wavep, lanep);
            else if (cls == 1) pool_item(p, l, idx, lds, tidp, wavep, lanep);
            else if (cls == 2) attn_item<0>(p, l, idx, lds, tidp, wavep, lanep);
            else if (cls == 3) attn_item<1>(p, l, idx, lds, tidp, wavep, lanep);
            else if (cls == 4) attn_item<2>(p, l, idx, lds, tidp, wavep, lanep);
            else attn_item<3>(p, l, idx, lds, tidp, wavep, lanep);
        }
#endif
        { XcdBarrier xb_; xb_.bar = (unsigned*)(p.ws + WS_CTL); xb_.x = xb_xcc_id(); xb_.st = (volatile LAS unsigned*)(lds + LDS_BYTES - 64); xcd_barrier(xb_); }
#if PH_MASK & 4
        { int tidp = threadIdx.x; asm volatile("" : "+v"(tidp)); combine_phase(p, bx * NTHREADS + tidp, G * NTHREADS); }
#endif
        { XcdBarrier xb_; xb_.bar = (unsigned*)(p.ws + WS_CTL); xb_.x = xb_xcc_id(); xb_.st = (volatile LAS unsigned*)(lds + LDS_BYTES - 64); xcd_barrier(xb_); }
#if PH_MASK & 8
        { int tidp = threadIdx.x; asm volatile("" : "+v"(tidp));
            pg8::Gemm g{proj, (const bf16_t*)(ws + WS_WBR) + (size_t)l * 4 * DM * BW, DIN, BW, BW};
            pg8::MergeOrder S; S.base.init(NTOK, DM, G, bx); S.bstep = (long)DM * BW * 2; S.a0 = C_AU * 2; S.a1 = C_PG * 2; S.a2 = C_CG * 2; S.a3 = C_MG * 2; S.astep = 0;
            pg8::EpiMerge E{proj + C_GM, DIN, (bf16_t*)(ws + WS_Z)};
            pg8::gemm_phase<pg8::EpiMerge, pg8::MergeOrder, true, true>(lds, g, S, E, tidp);
        }
#endif
        { XcdBarrier xb_; xb_.bar = (unsigned*)(p.ws + WS_CTL); xb_.x = xb_xcc_id(); xb_.st = (volatile LAS unsigned*)(lds + LDS_BYTES - 64); xcd_barrier(xb_); }
#if PH_MASK & 16
        { int tidp = threadIdx.x; asm volatile("" : "+v"(tidp));
            pg8::Gemm g{(const bf16_t*)(ws + WS_Z), (const bf16_t*)(ws + WS_WOUT) + (size_t)l * DM * DM, DM, DM, DM};
            pg8::StaticOrder S; S.init(NTOK, DM, G, bx);
            pg8::EpiOut E{l == 0 ? p.x : p.out, p.out, (bf16_t*)(ws + WS_XB), (float*)(ws + WS_ROWSS) + (size_t)(l + 1) * NTOK, ws + WS_XB8, l < DEPTH - 1};
            pg8::gemm_phase<pg8::EpiOut, pg8::StaticOrder, true, true>(lds, g, S, E, tidp);
        }
#endif
        { XcdBarrier xb_; xb_.bar = (unsigned*)(p.ws + WS_CTL); xb_.x = xb_xcc_id(); xb_.st = (volatile LAS unsigned*)(lds + LDS_BYTES - 64); xcd_barrier(xb_); }
    }
    {
        int tidf = threadIdx.x; asm volatile("" : "+v"(tidf)); const int lane = tidf & 63, wave = __builtin_amdgcn_readfirstlane(tidf >> 6);
        const int gw = vcu * NWAVES + wave, NGW = G * NWAVES; const float* ss = (const float*)(ws + WS_ROWSS) + (size_t)DEPTH * NTOK;
        f32x4 gg[4];
#pragma unroll
        for (int j = 0; j < 4; ++j) gg[j] = ((const f32x4*)p.final_norm_g)[lane + 64 * j];
        for (int m0 = gw; m0 < NTOK; m0 += 4 * NGW) {
            f32x4 v[4][4]; float sq[4];
#pragma unroll
            for (int i = 0; i < 4; ++i) { int m = m0 + i * NGW; if (m >= NTOK) m = m0; sq[i] = ss[m]; const f32x4* xr = (const f32x4*)(p.out + (size_t)m * DM) + lane;
#pragma unroll
                for (int j = 0; j < 4; ++j) v[i][j] = xr[64 * j]; }
            asm volatile("" ::: "memory");
#pragma unroll
            for (int i = 0; i < 4; ++i) { const int m = m0 + i * NGW; if (m >= NTOK) continue; const float rs = 1.0f / sqrtf(sq[i] * (1.0f / 1024.0f) + EPS); f32x4* xr = (f32x4*)(p.out + (size_t)m * DM) + lane;
#pragma unroll
                for (int j = 0; j < 4; ++j) xr[64 * j] = v[i][j] * rs * gg[j]; }
            asm volatile("" ::: "memory");
        }
    }
}

extern "C" void kernel_launch(void* const* d_in, const int* in_sizes, int n_in, void* d_out, int out_size, void* d_ws, size_t ws_size, hipStream_t stream) {
    static int grid = 0;
    if (grid == 0) {
        if (n_in != 15 || in_sizes[0] != NTOK * DM || out_size != NTOK * DM || ws_size < WS_END) { fprintf(stderr, "kernel_launch: unexpected shapes (n_in %d, in0 %d, out %d, ws %zu, need %zu)\n", n_in, n_in > 0 ? in_sizes[0] : -1, out_size, ws_size, (size_t)WS_END); grid = -1; return; }
        int dev = 0, cus = 0, per_cu = 0;
        hipGetDevice(&dev); hipDeviceGetAttribute(&cus, hipDeviceAttributeMultiprocessorCount, dev);
        if (hipFuncSetAttribute((const void*)mega_fwd, hipFuncAttributeMaxDynamicSharedMemorySize, LDS_BYTES) != hipSuccess) { fprintf(stderr, "kernel_launch: hipFuncSetAttribute failed\n"); grid = -1; return; }
        if (hipOccupancyMaxActiveBlocksPerMultiprocessor(&per_cu, (const void*)mega_fwd, NTHREADS, LDS_BYTES) != hipSuccess || per_cu < 1) { fprintf(stderr, "kernel_launch: occupancy query says %d blocks/CU\n", per_cu); grid = -1; return; }
        (void)hipGetLastError();
        grid = cus;
    }
    if (grid < 0) return;
    if (hipMemsetAsync((char*)d_ws + WS_CTL, 0, 16384, stream) != hipSuccess) { fprintf(stderr, "kernel_launch: memset failed\n"); return; }
    Params p{};
    p.x = (const float*)d_in[0]; p.mem = (const float*)d_in[1]; p.norm_g = (const float*)d_in[2]; p.w_in = (const float*)d_in[3]; p.gm_ln_g = (const float*)d_in[4]; p.gm_ln_b = (const float*)d_in[5];
    p.gm_ws = (const float*)d_in[6]; p.gm_bs = (const float*)d_in[7]; p.pool_w = (const float*)d_in[8]; p.pool_scale = (const float*)d_in[9]; p.mem_norm_g = (const float*)d_in[10];
    p.w_mem_kv = (const float*)d_in[11]; p.w_branch = (const float*)d_in[12]; p.w_out = (const float*)d_in[13]; p.final_norm_g = (const float*)d_in[14];
    p.out = (float*)d_out; p.ws = (unsigned char*)d_ws;
    void* args[] = {&p};
    hipError_t e = hipLaunchCooperativeKernel((const void*)mega_fwd, dim3(grid), dim3(NTHREADS), args, LDS_BYTES, stream);
    if (e != hipSuccess) fprintf(stderr, "kernel_launch: cooperative launch failed: %s (grid %d)\n", hipGetErrorString(e), grid);
}
```
